# Optimizing an MI355X kernel written in HIP

```python
import jax, jax.numpy as jnp
from jax import lax
import numpy as np

D_MODEL = 1024
BATCH = 4
SEQ = 8192
DEPTH = 1

D_MIX = D_MODEL
D_POOL = D_MIX // 2
D_CONV = D_MIX - D_POOL
POOL_WINDOWS = (2, 4, 8, 16)
N_POOL_GROUPS = len(POOL_WINDOWS)
POOL_GROUP = D_POOL // N_POOL_GROUPS
CONV_WIDTH = 31
N_CONV_HEADS = 4
CONV_HEAD = D_CONV // N_CONV_HEADS
D_IN = D_POOL + 2 * D_CONV
N_GROUPS = 4
EXPERTS_PER_GROUP = 8
N_EXPERTS = N_GROUPS * EXPERTS_PER_GROUP
TOP_K_FINE = 2
D_EXPERT = D_MODEL // 2
MOE_BLOCK = 128
D_PLE = 256
LN_EPS = 1e-5
DN_ALPHA = (2 * DEPTH) ** 0.25
DN_BETA = (8 * DEPTH) ** -0.25

kernel_name = "hybrid_pool_conv_hmoe_deepnorm"


def layer_norm(x, g, b):
    xf = x.astype(jnp.float32)
    mu = xf.mean(-1, keepdims=True)
    var = jnp.square(xf - mu).mean(-1, keepdims=True)
    return ((xf - mu) * lax.rsqrt(var + LN_EPS) * g + b).astype(x.dtype)


def causal_multiscale_pool(u):
    B, S, _ = u.shape
    ug = u.astype(jnp.float32).reshape(B, S, N_POOL_GROUPS, POOL_GROUP)
    csp = jnp.pad(jnp.cumsum(ug, axis=1), ((0, 0), (1, 0), (0, 0), (0, 0)))
    t = jnp.arange(S)
    outs = []
    for gi, w in enumerate(POOL_WINDOWS):
        start = jnp.maximum(t + 1 - w, 0)
        window_sum = csp[:, 1:, gi] - csp[:, start, gi]
        count = jnp.minimum(t + 1, w).astype(jnp.float32)
        outs.append(window_sum / count[None, :, None] - ug[:, :, gi])
    return jnp.stack(outs, axis=2)


def conformer_conv(a, b, w_dw, b_dw, g, beta):
    u = a * jax.nn.sigmoid(b)
    B, S, C = u.shape
    y = lax.conv_general_dilated(
        u, w_dw.astype(u.dtype)[:, None, :], window_strides=(1,),
        padding=[(CONV_WIDTH - 1, 0)], dimension_numbers=("NWC", "WIO", "NWC"),
        feature_group_count=C) + b_dw
    yh = layer_norm(y.reshape(B, S, N_CONV_HEADS, CONV_HEAD),
                    g.reshape(N_CONV_HEADS, CONV_HEAD), beta.reshape(N_CONV_HEADS, CONV_HEAD))
    return jax.nn.silu(yh.reshape(B, S, C))


def grouped_expert_ffn(hf, expert, weights, w_gate, w_up, w_down):
    T, D = hf.shape
    A = expert.size
    e_flat = expert.reshape(A)
    tok = jnp.repeat(jnp.arange(T, dtype=jnp.int32), TOP_K_FINE)
    w_flat = weights.reshape(A)
    order = jnp.argsort(e_flat)
    e_s, tok_s, w_s = e_flat[order], tok[order], w_flat[order]
    counts = jnp.bincount(e_flat, length=N_EXPERTS)
    padded = (counts + MOE_BLOCK - 1) // MOE_BLOCK * MOE_BLOCK
    start = jnp.cumsum(counts) - counts
    pend = jnp.cumsum(padded)
    pstart = pend - padded
    dest = pstart[e_s] + jnp.arange(A) - start[e_s]
    n_blocks = -(-A // MOE_BLOCK) + N_EXPERTS
    P = n_blocks * MOE_BLOCK
    buf_tok = jnp.full((P,), T, jnp.int32).at[dest].set(tok_s)
    buf_w = jnp.zeros((P,), jnp.float32).at[dest].set(w_s)
    block_expert = jnp.minimum(
        jnp.searchsorted(pend, jnp.arange(n_blocks) * MOE_BLOCK, side="right"), N_EXPERTS - 1)
    h_pad = jnp.concatenate([hf, jnp.zeros((1, D), hf.dtype)], axis=0)
    xb = h_pad[buf_tok].reshape(n_blocks, MOE_BLOCK, D)

    def block_ffn(args):
        xblk, e = args
        return (jax.nn.silu(xblk @ w_gate[e]) * (xblk @ w_up[e])) @ w_down[e]

    yb = lax.map(block_ffn, (xb, block_expert)).reshape(P, D)
    y = jax.ops.segment_sum(yb * buf_w[:, None].astype(yb.dtype), buf_tok, num_segments=T + 1)
    return y[:T]


def hierarchical_moe(h, w_coarse, b_coarse, w_fine, b_fine, w_gate, w_up, w_down):
    B, S, D = h.shape
    T = B * S
    hf = h.reshape(T, D)
    coarse = jax.nn.softmax((hf @ w_coarse).astype(jnp.float32) + b_coarse, axis=-1)
    p_group, g_idx = lax.top_k(coarse, 1)
    fine_logits = ((hf @ w_fine).astype(jnp.float32) + b_fine).reshape(T, N_GROUPS, EXPERTS_PER_GROUP)
    sel = jnp.take_along_axis(fine_logits, g_idx[:, :, None], axis=1)[:, 0]
    p_fine, e_local = lax.top_k(jax.nn.softmax(sel, axis=-1), TOP_K_FINE)
    p_fine = p_fine / p_fine.sum(-1, keepdims=True)
    weights = p_group * p_fine
    expert = g_idx * EXPERTS_PER_GROUP + e_local
    y = grouped_expert_ffn(hf, expert, weights, w_gate, w_up, w_down)
    return y.reshape(B, S, D)


def setup_inputs(seed: int = 0) -> dict:
    key = jax.random.key(seed)
    k = jax.random.split(key, 26)
    f32 = jnp.float32
    nrm = lambda kk, shape, s: jax.random.normal(kk, shape, f32) * s
    L = DEPTH
    return {
        "x": nrm(k[0], (BATCH, SEQ, D_MODEL), 1.0),
        "p": nrm(k[1], (DEPTH, BATCH, SEQ, D_PLE), 1.0),
        "w_in": nrm(k[2], (L, D_MODEL, D_IN), D_MODEL ** -0.5),
        "w_pool_mix": nrm(k[3], (L, N_POOL_GROUPS, POOL_GROUP, POOL_GROUP), POOL_GROUP ** -0.5),
        "pool_scale": 1.0 + nrm(k[4], (L, D_POOL), 0.1),
        "w_dw": nrm(k[5], (L, CONV_WIDTH, D_CONV), CONV_WIDTH ** -0.5),
        "b_dw": nrm(k[6], (L, D_CONV), 0.01),
        "conv_ln_g": 1.0 + nrm(k[7], (L, D_CONV), 0.05),
        "conv_ln_b": nrm(k[8], (L, D_CONV), 0.01),
        "w_out": nrm(k[9], (L, D_MIX, D_MODEL), D_MIX ** -0.5 * DN_BETA),
        "ln1_g": 1.0 + nrm(k[10], (L, D_MODEL), 0.05),
        "ln1_b": nrm(k[11], (L, D_MODEL), 0.01),
        "w_coarse": nrm(k[12], (L, D_MODEL, N_GROUPS), D_MODEL ** -0.5),
        "b_coarse": nrm(k[13], (L, N_GROUPS), 0.01),
        "w_fine": nrm(k[14], (L, D_MODEL, N_EXPERTS), D_MODEL ** -0.5),
        "b_fine": nrm(k[15], (L, N_EXPERTS), 0.01),
        "w_gate": nrm(k[16], (L, N_EXPERTS, D_MODEL, D_EXPERT), D_MODEL ** -0.5),
        "w_up": nrm(k[17], (L, N_EXPERTS, D_MODEL, D_EXPERT), D_MODEL ** -0.5),
        "w_down": nrm(k[18], (L, N_EXPERTS, D_EXPERT, D_MODEL), D_EXPERT ** -0.5 * DN_BETA),
        "ln2_g": 1.0 + nrm(k[19], (L, D_MODEL), 0.05),
        "ln2_b": nrm(k[20], (L, D_MODEL), 0.01),
        "w_ple_proj": nrm(k[21], (L, D_PLE, D_MODEL), D_PLE ** -0.5 * DN_BETA),
        "w_ple_gate": nrm(k[22], (L, D_MODEL, D_MODEL), D_MODEL ** -0.5),
        "ln3_g": 1.0 + nrm(k[23], (L, D_MODEL), 0.05),
        "ln3_b": nrm(k[24], (L, D_MODEL), 0.01),
    }


def reference(x, p, w_in, w_pool_mix, pool_scale, w_dw, b_dw, conv_ln_g, conv_ln_b, w_out,
              ln1_g, ln1_b, w_coarse, b_coarse, w_fine, b_fine, w_gate, w_up, w_down,
              ln2_g, ln2_b, w_ple_proj, w_ple_gate, ln3_g, ln3_b):
    B, S, _ = x.shape
    for i in range(DEPTH):
        z = x @ w_in[i]
        u_pool = z[..., :D_POOL]
        u_a = z[..., D_POOL:D_POOL + D_CONV]
        u_b = z[..., D_POOL + D_CONV:]
        pooled = causal_multiscale_pool(u_pool)
        pool_out = (jnp.einsum("bsgc,gcd->bsgd", pooled, w_pool_mix[i]).reshape(B, S, D_POOL)
                    * pool_scale[i]).astype(x.dtype)
        conv_out = conformer_conv(u_a, u_b, w_dw[i], b_dw[i], conv_ln_g[i], conv_ln_b[i])
        mix = jnp.concatenate([pool_out, conv_out], axis=-1) @ w_out[i]
        h = layer_norm(DN_ALPHA * x + mix, ln1_g[i], ln1_b[i])
        moe = hierarchical_moe(h, w_coarse[i], b_coarse[i], w_fine[i], b_fine[i],
                               w_gate[i], w_up[i], w_down[i])
        y = layer_norm(DN_ALPHA * h + moe, ln2_g[i], ln2_b[i])
        ple = (p[i] @ w_ple_proj[i]) * jax.nn.sigmoid(y @ w_ple_gate[i])
        x = layer_norm(DN_ALPHA * y + ple, ln3_g[i], ln3_b[i])
    return x
```

```cpp
#include <hip/hip_runtime.h>
#include <hip/hip_fp16.h>
#include <cstdio>
#include <cstdint>

namespace {
constexpr int T = 32768, SEQ = 8192, D = 1024, DIN = 1536, DPOOL = 512, DCONV = 512, DEXP = 512, DPLE = 256;
constexpr int NEXP = 32, CW = 31;
constexpr float ALPHA = 1.189207115002721f;
constexpr float EPS = 1e-5f;
constexpr int NTHREADS = 512;
constexpr int NTILES = T / 64;
constexpr int XS = 1032;

constexpr int LDS_TILE = 0;
constexpr int LDS_AUX = 64 * XS * 2;
constexpr int LDS_RED = LDS_AUX + 25600;
constexpr int LDS_BAR = LDS_RED + 4096;
constexpr int LDS_BYTES = LDS_BAR + 16;
typedef _Float16 half8 __attribute__((ext_vector_type(8)));
typedef _Float16 half4 __attribute__((ext_vector_type(4)));
typedef _Float16 half2v __attribute__((ext_vector_type(2)));
typedef float f32x16 __attribute__((ext_vector_type(16)));
#define LAS __attribute__((address_space(3)))
#define MFMA(a, b, c) __builtin_amdgcn_mfma_f32_32x32x16_f16((a), (b), (c), 0, 0, 0)

constexpr size_t OFF_BAR  = 0;
constexpr size_t OFF_CNT  = 16384;
constexpr size_t CTRL_BYTES = 20480;
constexpr size_t OFF_LIST = CTRL_BYTES;
constexpr size_t OFF_WGT  = OFF_LIST + (size_t)NEXP * T * 4;
constexpr size_t OFF_WIN  = OFF_WGT + (size_t)2 * T * 4;
constexpr size_t OFF_WOUT = OFF_WIN + (size_t)DIN * D * 2;
constexpr size_t OFF_WR   = OFF_WOUT + (size_t)D * D * 2;
constexpr size_t OFF_WG   = OFF_WR + (size_t)64 * D * 2;
constexpr size_t OFF_WU   = OFF_WG + (size_t)NEXP * D * DEXP * 2;
constexpr size_t OFF_WD   = OFF_WU + (size_t)NEXP * D * DEXP * 2;
constexpr size_t OFF_WPP  = OFF_WD + (size_t)NEXP * D * DEXP * 2;
constexpr size_t OFF_WPG  = OFF_WPP + (size_t)DPLE * D * 2;
constexpr size_t OFF_Z    = OFF_WPG + (size_t)D * D * 2;
constexpr size_t OFF_CC   = OFF_Z + (size_t)T * DIN * 2;
constexpr size_t OFF_H    = OFF_CC + (size_t)T * D * 2;
constexpr size_t OFF_YB   = OFF_H + (size_t)T * D * 2;
constexpr size_t OFF_END  = OFF_YB + (size_t)2 * T * D * 2;

struct Params {
  const float *x, *p, *w_in, *w_pool_mix, *pool_scale, *w_dw, *b_dw, *conv_ln_g, *conv_ln_b, *w_out, *ln1_g, *ln1_b, *w_coarse, *b_coarse, *w_fine,
      *b_fine, *w_gate, *w_up, *w_down, *ln2_g, *ln2_b, *w_ple_proj, *w_ple_gate, *ln3_g, *ln3_b;
  float* out;
  char* ws;
};

__device__ __forceinline__ float sigmoidf_(float x) { return __builtin_amdgcn_rcpf(1.f + __expf(-x)); }
__device__ __forceinline__ float siluf_(float x) { return x * __builtin_amdgcn_rcpf(1.f + __expf(-x)); }

template <class F>
__device__ __forceinline__ void pack_mat(_Float16* __restrict__ dst, const int NB, const int K, const int N, F src, const int gtid, const int gth) {
  const int KT = K / 16, MT = N / 32;
  const int total = NB * MT * KT * 64;
  for (int idx = gtid; idx < total; idx += gth) {
    const int lane = idx & 63;
    int f = idx >> 6;
    const int kt = f % KT; f /= KT;
    const int mt = f % MT; const int b = f / MT;
    const int k0 = kt * 16 + (lane >> 5) * 8, n = mt * 32 + (lane & 31);
    half8 v;
#pragma unroll
    for (int j = 0; j < 8; ++j) v[j] = (_Float16)src(b, k0 + j, n);
    *(half8*)(dst + (size_t)idx * 8) = v;
  }
}

__device__ void phase_pack(const Params& P) {
  const int gtid = blockIdx.x * NTHREADS + threadIdx.x, gth = gridDim.x * NTHREADS;
  char* ws = P.ws;
  {
    _Float16* dst = (_Float16*)(ws + OFF_WIN);
    const int total = 48 * 64 * 64;
    for (int idx = gtid; idx < total; idx += gth) {
      const int lane = idx & 63;
      const int f = idx >> 6;
      const int kt = f & 63, mt = f >> 6;
      const int k0 = kt * 16 + (lane >> 5) * 8, n = mt * 32 + (lane & 31);
      half8 v;
      if (mt >= 16) {
#pragma unroll
        for (int j = 0; j < 8; ++j) v[j] = (_Float16)P.w_in[(size_t)(k0 + j) * DIN + n];
      } else {
        const int g = n >> 7, d = n & 127;
        float acc[8];
#pragma unroll
        for (int j = 0; j < 8; ++j) acc[j] = 0.f;
        const float* wpm = P.w_pool_mix + (size_t)g * 128 * 128 + d;
        const float* wi = P.w_in + (size_t)k0 * DIN + g * 128;
        for (int c = 0; c < 128; ++c) {
          const float m = wpm[c * 128];
#pragma unroll
          for (int j = 0; j < 8; ++j) acc[j] = fmaf(wi[(size_t)j * DIN + c], m, acc[j]);
        }
        const float sc = P.pool_scale[n];
#pragma unroll
        for (int j = 0; j < 8; ++j) v[j] = (_Float16)(acc[j] * sc);
      }
      *(half8*)(dst + (size_t)idx * 8) = v;
    }
  }
  pack_mat((_Float16*)(ws + OFF_WOUT), 1, D, D, [&](int, int k, int n) { return P.w_out[(size_t)k * D + n]; }, gtid, gth);
  pack_mat((_Float16*)(ws + OFF_WR), 1, D, 64, [&](int, int k, int n) { return n < 4 ? P.w_coarse[k * 4 + n] : (n < 36 ? P.w_fine[k * 32 + n - 4] : 0.f); }, gtid, gth);
  pack_mat((_Float16*)(ws + OFF_WPP), 1, DPLE, D, [&](int, int k, int n) { return P.w_ple_proj[(size_t)k * D + n]; }, gtid, gth);
  pack_mat((_Float16*)(ws + OFF_WPG), 1, D, D, [&](int, int k, int n) { return P.w_ple_gate[(size_t)k * D + n]; }, gtid, gth);
}

template <int NA, int PF>
__device__ __forceinline__ void gemm_core(const _Float16* const (&ab)[NA], const int lane_off, const int KT,
                                          const LAS _Float16* bp, const int nt_stride, f32x16 (&acc)[NA][2]) {
  half8 abuf[PF][NA];
#pragma unroll
  for (int s = 0; s < PF; ++s)
#pragma unroll
    for (int i = 0; i < NA; ++i) abuf[s][i] = *(const half8*)(ab[i] + s * 512 + lane_off);
  half8 bb[2][2];
  bb[0][0] = *(const LAS half8*)(bp);
  bb[0][1] = *(const LAS half8*)(bp + nt_stride);
#pragma unroll 1
  for (int kt = 0; kt < KT; kt += PF) {
#pragma unroll
    for (int s = 0; s < PF; ++s) {
      const int k = kt + s;
      const int kb = (k + 1 < KT) ? (k + 1) : (KT - 1);
      bb[(s + 1) & 1][0] = *(const LAS half8*)(bp + kb * 16);
      bb[(s + 1) & 1][1] = *(const LAS half8*)(bp + nt_stride + kb * 16);
      __builtin_amdgcn_sched_barrier(0);
#pragma unroll
      for (int i = 0; i < NA; ++i) {
        acc[i][0] = MFMA(abuf[s][i], bb[s & 1][0], acc[i][0]);
        acc[i][1] = MFMA(abuf[s][i], bb[s & 1][1], acc[i][1]);
      }
      const int kn = (k + PF < KT) ? (k + PF) : (KT - 1);
#pragma unroll
      for (int i = 0; i < NA; ++i) abuf[s][i] = *(const half8*)(ab[i] + kn * 512 + lane_off);
      __builtin_amdgcn_sched_barrier(0);
    }
  }
}

template <int NA>
__device__ __forceinline__ void zero_acc(f32x16 (&acc)[NA][2]) {
#pragma unroll
  for (int i = 0; i < NA; ++i)
#pragma unroll
    for (int n = 0; n < 2; ++n)
#pragma unroll
      for (int r = 0; r < 16; ++r) acc[i][n][r] = 0.f;
}

__device__ void phase_z_tile(const Params& P, LAS char* lds, const int tile) {
  const int tid = threadIdx.x, lane = tid & 63, wave = __builtin_amdgcn_readfirstlane(tid >> 6);
  const int r = lane & 31, hh = lane >> 5;
  LAS _Float16* xt = (LAS _Float16*)lds;
  const int t0 = tile * 64;
#pragma unroll 8
  for (int it = 0; it < 32; ++it) {
    const int idx = tid + it * NTHREADS;
    const int row = idx >> 8, c4 = idx & 255;
    const float4 v = *(const float4*)(P.x + (size_t)(t0 + row) * D + c4 * 4);
    half4 hv = {(_Float16)v.x, (_Float16)v.y, (_Float16)v.z, (_Float16)v.w};
    *(LAS half4*)(xt + row * XS + c4 * 4) = hv;
  }
  __syncthreads();
  const _Float16* wp = (const _Float16*)(P.ws + OFF_WIN);
  _Float16* zN = (_Float16*)(P.ws + OFF_Z);
  const LAS _Float16* bp = xt + r * XS + hh * 8;
#pragma unroll 1
  for (int pass = 0; pass < 2; ++pass) {
    f32x16 acc[3][2];
    zero_acc<3>(acc);
    const int mt0 = pass * 24 + wave * 3;
    const _Float16* const ab[3] = {wp + (size_t)mt0 * 64 * 512, wp + (size_t)(mt0 + 1) * 64 * 512, wp + (size_t)(mt0 + 2) * 64 * 512};
    gemm_core<3, 4>(ab, lane * 8, 64, bp, 32 * XS, acc);
#pragma unroll
    for (int i = 0; i < 3; ++i)
#pragma unroll
      for (int nt = 0; nt < 2; ++nt)
#pragma unroll
        for (int q = 0; q < 4; ++q) {
          half4 hv = {(_Float16)acc[i][nt][4 * q], (_Float16)acc[i][nt][4 * q + 1], (_Float16)acc[i][nt][4 * q + 2], (_Float16)acc[i][nt][4 * q + 3]};
          const size_t off = ((((size_t)tile * 48 + (mt0 + i)) * 2 + nt) * 4 + q) * 256 + lane * 4;
          *(half4*)(zN + off) = hv;
        }
  }
  __syncthreads();
}


__device__ __forceinline__ void ln_stats(const f32x16 (&v)[4][2], LAS float* red, const int wave, const int lane, float (&mu)[2], float (&rs)[2]) {
  const int r = lane & 31, hh = lane >> 5;
#pragma unroll
  for (int nt = 0; nt < 2; ++nt) {
    float s = 0.f, ss = 0.f;
#pragma unroll
    for (int i = 0; i < 4; ++i)
#pragma unroll
      for (int g = 0; g < 16; ++g) { const float x = v[i][nt][g]; s += x; ss = fmaf(x, x, ss); }
    s += __shfl_xor(s, 32);
    ss += __shfl_xor(ss, 32);
    if (hh == 0) { red[(wave * 64 + nt * 32 + r) * 2] = s; red[(wave * 64 + nt * 32 + r) * 2 + 1] = ss; }
  }
  __syncthreads();
#pragma unroll
  for (int nt = 0; nt < 2; ++nt) {
    float s = 0.f, ss = 0.f;
#pragma unroll
    for (int w = 0; w < 8; ++w) { s += red[(w * 64 + nt * 32 + r) * 2]; ss += red[(w * 64 + nt * 32 + r) * 2 + 1]; }
    const float m = s * (1.f / D);
    const float var = fmaxf(ss * (1.f / D) - m * m, 0.f);
    mu[nt] = m;
    rs[nt] = rsqrtf(var + EPS);
  }
}


constexpr int PACK_UNITS = 3 << 21;
__device__ __forceinline__ void pack_issue(const Params& P, const int u0, const int ustride, float (&pv)[3][8]) {
#pragma unroll
  for (int q = 0; q < 3; ++q) {
    const int u = u0 + q * ustride;
    if (u < PACK_UNITS) {
      const int m = u >> 21, idx = u & ((1 << 21) - 1), lane = idx & 63, f = idx >> 6, e = f >> 10;
      const int r = lane & 31, hh = lane >> 5;
      const float* src;
      int stride;
      if (m < 2) {
        const int kt = f & 63, mt = (f >> 6) & 15;
        src = (m == 0 ? P.w_gate : P.w_up) + ((size_t)e * D + kt * 16 + hh * 8) * DEXP + mt * 32 + r;
        stride = DEXP;
      } else {
        const int kt = f & 31, mt = (f >> 5) & 31;
        src = P.w_down + ((size_t)e * DEXP + kt * 16 + hh * 8) * D + mt * 32 + r;
        stride = D;
      }
#pragma unroll
      for (int j = 0; j < 8; ++j) pv[q][j] = src[(size_t)j * stride];
    }
  }
}
__device__ __forceinline__ void pack_commit(const Params& P, const int u0, const int ustride, const float (&pv)[3][8]) {
#pragma unroll
  for (int q = 0; q < 3; ++q) {
    const int u = u0 + q * ustride;
    if (u < PACK_UNITS) {
      half8 v;
#pragma unroll
      for (int j = 0; j < 8; ++j) v[j] = (_Float16)pv[q][j];
      *(half8*)((_Float16*)(P.ws + OFF_WG) + (size_t)u * 8) = v;
    }
  }
}
constexpr int RS = 100;
constexpr int WST_BYTES = 16 * RS * 2;
__device__ __forceinline__ void fill_issue_w(const _Float16* __restrict__ zN, const int tile, const int g, const bool has_prev, const int wave, const int lane,
                                             half4 (&za)[6], half4 (&zb)[6]) {
  const bool glu = g >= 4;
  const int mtl = (glu ? 16 + (g - 4) * 4 : g * 4) + (wave >> 1), q0 = (wave & 1) * 2;
#pragma unroll
  for (int uu = 0; uu < 6; ++uu) {
    const int st = uu >> 1, q = q0 + (uu & 1);
    const int ztile = (st == 0) ? tile - 1 : tile;
    const int nt = (st == 0) ? 1 : st - 1;
    const half4 z0 = {(_Float16)0.f, (_Float16)0.f, (_Float16)0.f, (_Float16)0.f};
    za[uu] = z0; zb[uu] = z0;
    if (st != 0 || has_prev) {
      const size_t off = ((((size_t)ztile * 48 + mtl) * 2 + nt) * 4 + q) * 256 + lane * 4;
      za[uu] = *(const half4*)(zN + off);
      if (glu) zb[uu] = *(const half4*)(zN + off + (size_t)16 * 2 * 4 * 256);
    }
  }
}
__device__ __forceinline__ void fill_commit_w(LAS _Float16* wst, const bool glu, const int lane, const half4 (&za)[6], const half4 (&zb)[6]) {
  const int r = lane & 31, hh = lane >> 5;
#pragma unroll
  for (int uu = 0; uu < 6; ++uu) {
    const int st = uu >> 1, qq = uu & 1;
#pragma unroll
    for (int e = 0; e < 4; ++e) {
      float v = (float)za[uu][e];
      if (glu) v *= sigmoidf_((float)zb[uu][e]);
      wst[(qq * 8 + hh * 4 + e) * RS + st * 32 + r] = (_Float16)v;
    }
  }
}
__device__ __forceinline__ float seg16_treduce(const float (&v)[16]) {
  const int lane = threadIdx.x & 63;
  float a8[8], a4[4], a2[2];
  {
    const bool up = (lane & 8) != 0;
#pragma unroll
    for (int i = 0; i < 8; ++i) { const float keep = up ? v[i + 8] : v[i], send = up ? v[i] : v[i + 8]; a8[i] = keep + __shfl_xor(send, 8); }
  }
  {
    const bool up = (lane & 4) != 0;
#pragma unroll
    for (int i = 0; i < 4; ++i) { const float keep = up ? a8[i + 4] : a8[i], send = up ? a8[i] : a8[i + 4]; a4[i] = keep + __shfl_xor(send, 4); }
  }
  {
    const bool up = (lane & 2) != 0;
#pragma unroll
    for (int i = 0; i < 2; ++i) { const float keep = up ? a4[i + 2] : a4[i], send = up ? a4[i] : a4[i + 2]; a2[i] = keep + __shfl_xor(send, 2); }
  }
  const bool up = (lane & 1) != 0;
  const float keep = up ? a2[1] : a2[0], send = up ? a2[0] : a2[1];
  return keep + __shfl_xor(send, 1);
}
template <int W>
__device__ __forceinline__ void pool_group_w(const LAS _Float16* wst, LAS _Float16* cc, const int g, const int s0, const int wave, const int lane) {
  const int c = lane & 15, tg = lane >> 4;
  float v[32];
#pragma unroll
  for (int i = 0; i < 16; ++i) {
    const half2v p = *(const LAS half2v*)(wst + c * RS + 16 + tg * 16 + 2 * i);
    v[2 * i] = (float)p[0]; v[2 * i + 1] = (float)p[1];
  }
  float S = 0.f;
#pragma unroll
  for (int i = 0; i < W; ++i) S += v[16 - i];
#pragma unroll
  for (int j = 0; j < 16; ++j) {
    if (j > 0) S += v[16 + j] - v[16 + j - W];
    const int s = s0 + tg * 16 + j;
    const int cnt = (s + 1 < W) ? (s + 1) : W;
    const float o = S * __builtin_amdgcn_rcpf((float)cnt) - v[16 + j];
    cc[(tg * 16 + j) * XS + g * 128 + wave * 16 + c] = (_Float16)o;
  }
}

__device__ void phase_m_tile(const Params& P, LAS char* lds, const int tile, const int pack_base) {
  int tid_ = threadIdx.x;
  asm volatile("" : "+v"(tid_));
  const int tid = tid_, lane = tid & 63, wave = __builtin_amdgcn_readfirstlane(tid >> 6);
  const int r = lane & 31, hh = lane >> 5;
  const int t0 = tile * 64;
  const int s0 = t0 % SEQ;
  const bool has_prev = (s0 != 0);
  const _Float16* zN = (const _Float16*)(P.ws + OFF_Z);
  LAS _Float16* cc = (LAS _Float16*)(lds + LDS_TILE);
  LAS _Float16* ub = (LAS _Float16*)(lds + LDS_AUX);
  LAS float* red = (LAS float*)(lds + LDS_RED);

  const int ustride = gridDim.x * NTHREADS;
  int pu = pack_base + blockIdx.x * NTHREADS + tid;
  LAS _Float16* wst = (LAS _Float16*)(lds + LDS_AUX + wave * WST_BYTES);
  const int c16 = lane & 15, tg = lane >> 4;
  half4 za[6], zb[6];
  fill_issue_w(zN, tile, 0, has_prev, wave, lane, za, zb);
#pragma unroll 1
  for (int g = 0; g < 8; ++g) {
    const bool glu = g >= 4;
    const int hd = g - 4, ch = (glu ? hd : 0) * 128 + wave * 16 + c16;
    fill_commit_w(wst, glu, lane, za, zb);
    if (g < 7) fill_issue_w(zN, tile, g + 1, has_prev, wave, lane, za, zb);
    float wv[CW];
    float bias = 0.f, g_ = 0.f, b_ = 0.f;
    if (glu) {
#pragma unroll
      for (int jj = 0; jj < CW; ++jj) wv[jj] = P.w_dw[jj * DCONV + ch];
      bias = P.b_dw[ch]; g_ = P.conv_ln_g[ch]; b_ = P.conv_ln_b[ch];
    } else {
#pragma unroll
      for (int jj = 0; jj < CW; ++jj) wv[jj] = 0.f;
    }
    float pv[3][8];
    pack_issue(P, pu, ustride, pv);
    if (!glu) {
      if (g == 0) pool_group_w<2>(wst, cc, 0, s0, wave, lane);
      else if (g == 1) pool_group_w<4>(wst, cc, 1, s0, wave, lane);
      else if (g == 2) pool_group_w<8>(wst, cc, 2, s0, wave, lane);
      else pool_group_w<16>(wst, cc, 3, s0, wave, lane);
    } else {
      float y[16];
      {
        float uv[46];
#pragma unroll
        for (int i = 0; i < 23; ++i) {
          const half2v p = *(const LAS half2v*)(wst + c16 * RS + tg * 16 + 2 + 2 * i);
          uv[2 * i] = (float)p[0]; uv[2 * i + 1] = (float)p[1];
        }
#pragma unroll
        for (int j = 0; j < 16; ++j) y[j] = bias;
#pragma unroll
        for (int jj = 0; jj < CW; ++jj) {
#pragma unroll
          for (int j = 0; j < 16; ++j) y[j] = fmaf(wv[jj], uv[j + jj], y[j]);
        }
      }
      float t1, t2;
      {
        float sq[16];
#pragma unroll
        for (int j = 0; j < 16; ++j) sq[j] = y[j] * y[j];
        t1 = seg16_treduce(y);
        t2 = seg16_treduce(sq);
      }
      __syncthreads();
      red[(wave * 64 + lane) * 2] = t1;
      red[(wave * 64 + lane) * 2 + 1] = t2;
      __syncthreads();
      float s1 = 0.f, s2 = 0.f;
#pragma unroll
      for (int w = 0; w < 8; ++w) { s1 += red[(w * 64 + lane) * 2]; s2 += red[(w * 64 + lane) * 2 + 1]; }
      const float m_l = s1 * (1.f / 128.f);
      const float r_l = rsqrtf(fmaxf(s2 * (1.f / 128.f) - m_l * m_l, 0.f) + EPS);
#pragma unroll
      for (int j = 0; j < 16; ++j) {
        const float m = __shfl(m_l, tg * 16 + j), rsd = __shfl(r_l, tg * 16 + j);
        const float v = (y[j] - m) * rsd * g_ + b_;
        cc[(tg * 16 + j) * XS + 512 + ch] = (_Float16)siluf_(v);
      }
    }
    pack_commit(P, pu, ustride, pv);
    pu += 3 * ustride;
  }
  __syncthreads();

  f32x16 acc[4][2];
  zero_acc<4>(acc);
  {
    const _Float16* wp = (const _Float16*)(P.ws + OFF_WOUT) + (size_t)(wave * 4) * 64 * 512;
    const _Float16* const ab[4] = {wp, wp + 64 * 512, wp + 2 * 64 * 512, wp + 3 * 64 * 512};
    gemm_core<4, 4>(ab, lane * 8, 64, cc + r * XS + hh * 8, 32 * XS, acc);
  }
#pragma unroll
  for (int i = 0; i < 4; ++i)
#pragma unroll
    for (int nt = 0; nt < 2; ++nt)
#pragma unroll
      for (int q = 0; q < 4; ++q) {
        const int ch0 = (wave * 4 + i) * 32 + q * 8 + hh * 4;
        const float4 xv = *(const float4*)(P.x + (size_t)(t0 + nt * 32 + r) * D + ch0);
        acc[i][nt][4 * q + 0] = fmaf(ALPHA, xv.x, acc[i][nt][4 * q + 0]);
        acc[i][nt][4 * q + 1] = fmaf(ALPHA, xv.y, acc[i][nt][4 * q + 1]);
        acc[i][nt][4 * q + 2] = fmaf(ALPHA, xv.z, acc[i][nt][4 * q + 2]);
        acc[i][nt][4 * q + 3] = fmaf(ALPHA, xv.w, acc[i][nt][4 * q + 3]);
      }
  float mu[2], rs[2];
  ln_stats(acc, red, wave, lane, mu, rs);
#pragma unroll
  for (int i = 0; i < 4; ++i)
#pragma unroll
    for (int q = 0; q < 4; ++q) {
      const int ch0 = (wave * 4 + i) * 32 + q * 8 + hh * 4;
      const float4 gv = *(const float4*)(P.ln1_g + ch0), bv = *(const float4*)(P.ln1_b + ch0);
#pragma unroll
      for (int nt = 0; nt < 2; ++nt) {
        half4 hv;
        hv[0] = (_Float16)((acc[i][nt][4 * q + 0] - mu[nt]) * rs[nt] * gv.x + bv.x);
        hv[1] = (_Float16)((acc[i][nt][4 * q + 1] - mu[nt]) * rs[nt] * gv.y + bv.y);
        hv[2] = (_Float16)((acc[i][nt][4 * q + 2] - mu[nt]) * rs[nt] * gv.z + bv.z);
        hv[3] = (_Float16)((acc[i][nt][4 * q + 3] - mu[nt]) * rs[nt] * gv.w + bv.w);
        *(LAS half4*)(cc + (nt * 32 + r) * XS + ch0) = hv;
      }
    }
  __syncthreads();
  LAS int* hist = (LAS int*)(lds + LDS_RED);
  if (tid < 64) hist[tid] = 0;
  {
    _Float16* hb = (_Float16*)(P.ws + OFF_H);
#pragma unroll 4
    for (int it = 0; it < 16; ++it) {
      const int idx = tid + it * NTHREADS;
      const int row = idx >> 7, ck = idx & 127;
      const half8 v = *(const LAS half8*)(cc + row * XS + ck * 8);
      *(half8*)(hb + (size_t)(t0 + row) * D + ck * 8) = v;
    }
  }
  LAS float* lg = (LAS float*)(lds + LDS_AUX);
  {
    const int ct = wave & 1, nt = (wave >> 1) & 1, kh = wave >> 2;
    f32x16 ra;
#pragma unroll
    for (int g = 0; g < 16; ++g) ra[g] = 0.f;
    const _Float16* ap = (const _Float16*)(P.ws + OFF_WR) + ((size_t)ct * 64 + kh * 32) * 512 + lane * 8;
    const LAS _Float16* bp = cc + (nt * 32 + r) * XS + kh * 512 + hh * 8;
#pragma unroll 4
    for (int kt = 0; kt < 32; ++kt) {
      const half8 a = *(const half8*)(ap + kt * 512);
      const half8 b = *(const LAS half8*)(bp + kt * 16);
      ra = MFMA(a, b, ra);
    }
    if (kh == 1) {
#pragma unroll
      for (int g = 0; g < 16; ++g) lg[(ct * 32 + (g & 3) + 8 * (g >> 2) + 4 * hh) * 64 + nt * 32 + r] = ra[g];
    }
    __syncthreads();
    if (kh == 0) {
#pragma unroll
      for (int g = 0; g < 16; ++g) lg[(ct * 32 + (g & 3) + 8 * (g >> 2) + 4 * hh) * 64 + nt * 32 + r] += ra[g];
    }
    __syncthreads();
  }
  int ex1 = 0, ex2 = 0, rk1 = 0, rk2 = 0;
  float wt1 = 0.f, wt2 = 0.f;
  if (tid < 64) {
    float lc[4];
#pragma unroll
    for (int i = 0; i < 4; ++i) lc[i] = lg[i * 64 + tid] + P.b_coarse[i];
    int g = 0; float mx = lc[0];
#pragma unroll
    for (int i = 1; i < 4; ++i) if (lc[i] > mx) { mx = lc[i]; g = i; }
    float den = 0.f;
#pragma unroll
    for (int i = 0; i < 4; ++i) den += __expf(lc[i] - mx);
    const float pg = 1.f / den;
    float sel[8];
#pragma unroll
    for (int i = 0; i < 8; ++i) sel[i] = lg[(4 + g * 8 + i) * 64 + tid] + P.b_fine[g * 8 + i];
    int e1 = 0; float m1 = sel[0];
#pragma unroll
    for (int i = 1; i < 8; ++i) if (sel[i] > m1) { m1 = sel[i]; e1 = i; }
    int e2 = -1; float m2 = -3.0e38f;
#pragma unroll
    for (int i = 0; i < 8; ++i) if (i != e1 && sel[i] > m2) { m2 = sel[i]; e2 = i; }
    const float q2 = __expf(m2 - m1);
    wt1 = pg / (1.f + q2);
    wt2 = pg * q2 / (1.f + q2);
    ex1 = g * 8 + e1; ex2 = g * 8 + e2;
    rk1 = atomicAdd((int*)&hist[ex1], 1);
    rk2 = atomicAdd((int*)&hist[ex2], 1);
  }
  __syncthreads();
  if (tid < 32) {
    const int n = hist[tid];
    int base = 0;
    if (n > 0) base = atomicAdd((int*)(P.ws + OFF_CNT) + tid, n);
    hist[32 + tid] = base;
  }
  __syncthreads();
  if (tid < 64) {
    int* list = (int*)(P.ws + OFF_LIST);
    float* wgt = (float*)(P.ws + OFF_WGT);
    const int t = t0 + tid;
    list[(size_t)ex1 * T + hist[32 + ex1] + rk1] = t * 2;
    list[(size_t)ex2 * T + hist[32 + ex2] + rk2] = t * 2 + 1;
    wgt[t * 2] = wt1;
    wgt[t * 2 + 1] = wt2;
  }
  __syncthreads();
}

constexpr int AS = 520;
__device__ void phase_f_tile(const Params& P, LAS char* lds, const int e, const int row0, const int nrows) {
  int tid_ = threadIdx.x;
  asm volatile("" : "+v"(tid_));
  const int tid = tid_, lane = tid & 63, wave = __builtin_amdgcn_readfirstlane(tid >> 6);
  const int r = lane & 31, hh = lane >> 5;
  LAS _Float16* cc = (LAS _Float16*)(lds + LDS_TILE);
  LAS int* la = (LAS int*)(lds + LDS_RED + 256);
  LAS float* lw = (LAS float*)(lds + LDS_RED + 512);
  if (tid < 64) {
    int a = -1; float w = 0.f;
    if (tid < nrows) { a = ((const int*)(P.ws + OFF_LIST))[(size_t)e * T + row0 + tid]; w = ((const float*)(P.ws + OFF_WGT))[a]; }
    la[tid] = a; lw[tid] = w;
  }
  __syncthreads();
  {
    const _Float16* hb = (const _Float16*)(P.ws + OFF_H);
#pragma unroll 4
    for (int it = 0; it < 16; ++it) {
      const int idx = tid + it * NTHREADS;
      const int row = idx >> 7, ck = idx & 127;
      const int a = la[row];
      half8 v = {(_Float16)0.f, (_Float16)0.f, (_Float16)0.f, (_Float16)0.f, (_Float16)0.f, (_Float16)0.f, (_Float16)0.f, (_Float16)0.f};
      if (a >= 0) v = *(const half8*)(hb + (size_t)(a >> 1) * D + ck * 8);
      *(LAS half8*)(cc + row * XS + ck * 8) = v;
    }
  }
  __syncthreads();
  f32x16 acc[4][2];
  zero_acc<4>(acc);
  {
    const _Float16* wg = (const _Float16*)(P.ws + OFF_WG) + (size_t)(e * 16 + wave * 2) * 64 * 512;
    const _Float16* wu = (const _Float16*)(P.ws + OFF_WU) + (size_t)(e * 16 + wave * 2) * 64 * 512;
    const _Float16* const ab[4] = {wg, wg + 64 * 512, wu, wu + 64 * 512};
    gemm_core<4, 4>(ab, lane * 8, 64, cc + r * XS + hh * 8, 32 * XS, acc);
  }
  __syncthreads();
  LAS _Float16* at = (LAS _Float16*)(lds + LDS_TILE);
#pragma unroll
  for (int i = 0; i < 2; ++i)
#pragma unroll
    for (int nt = 0; nt < 2; ++nt)
#pragma unroll
      for (int q = 0; q < 4; ++q) {
        half4 hv;
#pragma unroll
        for (int j = 0; j < 4; ++j) hv[j] = (_Float16)(siluf_(acc[i][nt][4 * q + j]) * acc[i + 2][nt][4 * q + j]);
        *(LAS half4*)(at + (nt * 32 + r) * AS + wave * 64 + i * 32 + q * 8 + hh * 4) = hv;
      }
  __syncthreads();
  zero_acc<4>(acc);
  {
    const _Float16* wd = (const _Float16*)(P.ws + OFF_WD) + (size_t)(e * 32 + wave * 4) * 32 * 512;
    const _Float16* const ab[4] = {wd, wd + 32 * 512, wd + 2 * 32 * 512, wd + 3 * 32 * 512};
    gemm_core<4, 4>(ab, lane * 8, 32, at + r * AS + hh * 8, 32 * AS, acc);
  }
  __syncthreads();
  {
    const float w0 = lw[r], w1 = lw[32 + r];
#pragma unroll
    for (int i = 0; i < 4; ++i)
#pragma unroll
      for (int nt = 0; nt < 2; ++nt)
#pragma unroll
        for (int q = 0; q < 4; ++q) {
          const float w = nt ? w1 : w0;
          half4 hv;
#pragma unroll
          for (int j = 0; j < 4; ++j) hv[j] = (_Float16)(acc[i][nt][4 * q + j] * w);
          *(LAS half4*)(cc + (nt * 32 + r) * XS + (wave * 4 + i) * 32 + q * 8 + hh * 4) = hv;
        }
  }
  __syncthreads();
  {
    _Float16* yb = (_Float16*)(P.ws + OFF_YB);
#pragma unroll 4
    for (int it = 0; it < 16; ++it) {
      const int idx = tid + it * NTHREADS;
      const int row = idx >> 7, ck = idx & 127;
      const int a = la[row];
      if (a >= 0) *(half8*)(yb + (size_t)a * D + ck * 8) = *(const LAS half8*)(cc + row * XS + ck * 8);
    }
  }
  __syncthreads();
}

__device__ void phase_f(const Params& P, LAS char* lds, const unsigned xcc, const unsigned xrank) {
  LAS int* sm = (LAS int*)(lds + LDS_RED);
  const int* counts = (const int*)(P.ws + OFF_CNT);
  if (threadIdx.x == 0) {
    int a = 0;
    for (int e = 0; e < NEXP; ++e) { sm[e] = a; a += (counts[e] + 63) >> 6; }
    sm[32] = a;
  }
  __syncthreads();
  const int total = sm[32];
  int vb = 0;
  for (unsigned x = 0; x < xcc; ++x) vb += (int)__hip_atomic_load((unsigned*)(P.ws + OFF_CNT + 2048) + 16 * x, __ATOMIC_RELAXED, __HIP_MEMORY_SCOPE_AGENT);
  vb += (int)xrank;
  for (int vt = vb; vt < total; vt += gridDim.x) {
    int e = 0;
    for (int i = 1; i < NEXP; ++i) e += (sm[i] <= vt) ? 1 : 0;
    const int row0 = (vt - sm[e]) * 64;
    const int cnt = counts[e];
    const int nrows = (cnt - row0 < 64) ? (cnt - row0) : 64;
    phase_f_tile(P, lds, e, row0, nrows);
  }
}

constexpr int PS = 264;
__device__ void phase_l_tile(const Params& P, LAS char* lds, const int tile) {
  int tid_ = threadIdx.x;
  asm volatile("" : "+v"(tid_));
  const int tid = tid_, lane = tid & 63, wave = __builtin_amdgcn_readfirstlane(tid >> 6);
  const int r = lane & 31, hh = lane >> 5;
  const int t0 = tile * 64;
  LAS _Float16* cc = (LAS _Float16*)(lds + LDS_TILE);
  LAS float* red = (LAS float*)(lds + LDS_RED);
  _Float16* scr = (_Float16*)(P.ws + OFF_Z) + (size_t)blockIdx.x * 16 * NTHREADS * 8;
  {
    LAS _Float16* pt = (LAS _Float16*)(lds + LDS_TILE);
#pragma unroll
    for (int it = 0; it < 8; ++it) {
      const int idx = tid + it * NTHREADS;
      const int row = idx >> 6, c4 = idx & 63;
      const float4 v = *(const float4*)(P.p + (size_t)(t0 + row) * DPLE + c4 * 4);
      half4 hv = {(_Float16)v.x, (_Float16)v.y, (_Float16)v.z, (_Float16)v.w};
      *(LAS half4*)(pt + row * PS + c4 * 4) = hv;
    }
  }
  __syncthreads();
  f32x16 acc[4][2];
  zero_acc<4>(acc);
  {
    const _Float16* wp = (const _Float16*)(P.ws + OFF_WPP) + (size_t)(wave * 4) * 16 * 512;
    const _Float16* const ab[4] = {wp, wp + 16 * 512, wp + 2 * 16 * 512, wp + 3 * 16 * 512};
    gemm_core<4, 4>(ab, lane * 8, 16, cc + r * PS + hh * 8, 32 * PS, acc);
  }
#pragma unroll
  for (int i = 0; i < 4; ++i)
#pragma unroll
    for (int nt = 0; nt < 2; ++nt)
#pragma unroll
      for (int hf = 0; hf < 2; ++hf) {
        half8 hv;
#pragma unroll
        for (int j = 0; j < 8; ++j) hv[j] = (_Float16)acc[i][nt][hf * 8 + j];
        *(half8*)(scr + ((size_t)((i * 2 + nt) * 2 + hf) * NTHREADS + tid) * 8) = hv;
      }
  __syncthreads();
  {
    const _Float16* hb = (const _Float16*)(P.ws + OFF_H);
    const _Float16* yb = (const _Float16*)(P.ws + OFF_YB);
    float g2[16], b2[16];
#pragma unroll
    for (int hf = 0; hf < 2; ++hf)
#pragma unroll
      for (int j4 = 0; j4 < 2; ++j4) {
        const float4 gv = *(const float4*)(P.ln2_g + hf * 512 + lane * 8 + j4 * 4), bv = *(const float4*)(P.ln2_b + hf * 512 + lane * 8 + j4 * 4);
        g2[hf * 8 + j4 * 4 + 0] = gv.x; g2[hf * 8 + j4 * 4 + 1] = gv.y; g2[hf * 8 + j4 * 4 + 2] = gv.z; g2[hf * 8 + j4 * 4 + 3] = gv.w;
        b2[hf * 8 + j4 * 4 + 0] = bv.x; b2[hf * 8 + j4 * 4 + 1] = bv.y; b2[hf * 8 + j4 * 4 + 2] = bv.z; b2[hf * 8 + j4 * 4 + 3] = bv.w;
      }
#pragma unroll 2
    for (int k = 0; k < 8; ++k) {
      const int row = wave * 8 + k;
      const size_t t = (size_t)(t0 + row);
      float v[16];
      float s = 0.f, ss = 0.f;
#pragma unroll
      for (int hf = 0; hf < 2; ++hf) {
        const half8 hv = *(const half8*)(hb + t * D + hf * 512 + lane * 8);
        const half8 y0 = *(const half8*)(yb + (2 * t) * D + hf * 512 + lane * 8);
        const half8 y1 = *(const half8*)(yb + (2 * t + 1) * D + hf * 512 + lane * 8);
#pragma unroll
        for (int j = 0; j < 8; ++j) {
          const float x = fmaf(ALPHA, (float)hv[j], (float)y0[j] + (float)y1[j]);
          v[hf * 8 + j] = x; s += x; ss = fmaf(x, x, ss);
        }
      }
#pragma unroll
      for (int o = 32; o > 0; o >>= 1) { s += __shfl_xor(s, o); ss += __shfl_xor(ss, o); }
      const float m = s * (1.f / D);
      const float rsd = rsqrtf(fmaxf(ss * (1.f / D) - m * m, 0.f) + EPS);
#pragma unroll
      for (int hf = 0; hf < 2; ++hf) {
        half8 o8;
#pragma unroll
        for (int j = 0; j < 8; ++j) o8[j] = (_Float16)((v[hf * 8 + j] - m) * rsd * g2[hf * 8 + j] + b2[hf * 8 + j]);
        *(LAS half8*)(cc + row * XS + hf * 512 + lane * 8) = o8;
      }
    }
  }
  __syncthreads();
  zero_acc<4>(acc);
  {
    const _Float16* wp = (const _Float16*)(P.ws + OFF_WPG) + (size_t)(wave * 4) * 64 * 512;
    const _Float16* const ab[4] = {wp, wp + 64 * 512, wp + 2 * 64 * 512, wp + 3 * 64 * 512};
    gemm_core<4, 2>(ab, lane * 8, 64, cc + r * XS + hh * 8, 32 * XS, acc);
  }
#pragma unroll
  for (int i = 0; i < 4; ++i)
#pragma unroll
    for (int nt = 0; nt < 2; ++nt)
#pragma unroll
      for (int hf = 0; hf < 2; ++hf) {
        const half8 pv = *(const half8*)(scr + ((size_t)((i * 2 + nt) * 2 + hf) * NTHREADS + tid) * 8);
#pragma unroll
        for (int q2 = 0; q2 < 2; ++q2) {
          const int q = hf * 2 + q2;
          const half4 yv = *(const LAS half4*)(cc + (nt * 32 + r) * XS + (wave * 4 + i) * 32 + q * 8 + hh * 4);
#pragma unroll
          for (int j = 0; j < 4; ++j) {
            const float gate = sigmoidf_(acc[i][nt][4 * q + j]);
            acc[i][nt][4 * q + j] = fmaf(ALPHA, (float)yv[j], (float)pv[q2 * 4 + j] * gate);
          }
        }
      }
  float mu[2], rs[2];
  ln_stats(acc, red, wave, lane, mu, rs);
#pragma unroll
  for (int i = 0; i < 4; ++i)
#pragma unroll
    for (int q = 0; q < 4; ++q) {
      const int ch0 = (wave * 4 + i) * 32 + q * 8 + hh * 4;
      const float4 gv = *(const float4*)(P.ln3_g + ch0), bv = *(const float4*)(P.ln3_b + ch0);
#pragma unroll
      for (int nt = 0; nt < 2; ++nt) {
        float4 o;
        o.x = (acc[i][nt][4 * q + 0] - mu[nt]) * rs[nt] * gv.x + bv.x;
        o.y = (acc[i][nt][4 * q + 1] - mu[nt]) * rs[nt] * gv.y + bv.y;
        o.z = (acc[i][nt][4 * q + 2] - mu[nt]) * rs[nt] * gv.z + bv.z;
        o.w = (acc[i][nt][4 * q + 3] - mu[nt]) * rs[nt] * gv.w + bv.w;
        *(float4*)(P.out + (size_t)(t0 + nt * 32 + r) * D + ch0) = o;
      }
    }
  __syncthreads();
}

#define XB_TMO      128
#define XB_XCNT(j)  (256  + 64 * (j))
#define XB_XSUB(j)  (1280 + 64 * (j))
#define XB_XGEN(j)  (2304 + 64 * (j))
#define XB_TOP      3328
#define XB_TOPGEN   3392
#define XCD_BAR_WORDS 3456
#define XB_SPIN_CAP (1u << 18)
__device__ __forceinline__ unsigned xb_ld(unsigned* p)              { return __hip_atomic_load(p, __ATOMIC_RELAXED, __HIP_MEMORY_SCOPE_AGENT); }
__device__ __forceinline__ unsigned xb_add(unsigned* p, unsigned v) { return __hip_atomic_fetch_add(p, v, __ATOMIC_RELAXED, __HIP_MEMORY_SCOPE_AGENT); }
__device__ __forceinline__ unsigned xb_xcc_id() { return (unsigned)__builtin_amdgcn_s_getreg((3 << 11) | 20) & 0xFu; }
#define XB_SPIN(cond, bar) do { unsigned _sp = 0; while (cond) { __builtin_amdgcn_s_sleep(1); \
    if ((++_sp & 255u) == 0u) { if (xb_ld(&(bar)[XB_TMO])) break; if (_sp > XB_SPIN_CAP) { atomicAdd(&(bar)[XB_TMO], 1u); break; } } } } while (0)
struct XcdBarrier { unsigned* bar; unsigned x; volatile LAS unsigned* st; };
__device__ __forceinline__ XcdBarrier xcd_barrier_post(unsigned* bar, volatile LAS unsigned* st) {
  XcdBarrier b; b.bar = bar; b.x = xb_xcc_id(); b.st = st;
  if (threadIdx.x == 0) (void)xb_add(&bar[XB_XCNT(b.x)], 1u);
  return b;
}
__device__ __forceinline__ void xcd_barrier_complete(unsigned* bar, unsigned x, unsigned& nloc, unsigned& nx) {
  const unsigned G = gridDim.x * gridDim.y * gridDim.z;
  unsigned sum, cnt, mine, sp = 0u;
  for (;;) {
    sum = 0u; cnt = 0u; mine = 0u;
#pragma unroll
    for (unsigned j = 0; j < 16; ++j) { const unsigned c = xb_ld(&bar[XB_XCNT(j)]); sum += c; cnt += (c > 0u) ? 1u : 0u; mine = (j == x) ? c : mine; }
    if (sum == G) break;
    __builtin_amdgcn_s_sleep(1);
    if ((++sp & 255u) == 0u) { if (xb_ld(&bar[XB_TMO])) break; if (sp > XB_SPIN_CAP) { atomicAdd(&bar[XB_TMO], 1u); break; } }
  }
  nloc = mine > 0u ? mine : 1u; nx = cnt > 0u ? cnt : 1u;
}
__device__ __forceinline__ void xcd_barrier(const XcdBarrier& b) {
  asm volatile("s_waitcnt vmcnt(0)" ::: "memory");
  __syncthreads();
  if (threadIdx.x == 0) {
    unsigned* bar = b.bar;
    __builtin_amdgcn_s_waitcnt(0);
    unsigned nloc = b.st[0], nx = b.st[1];
    if (nloc == 0u) { xcd_barrier_complete(bar, b.x, nloc, nx); b.st[0] = nloc; b.st[1] = nx; }
    const unsigned old = xb_add(&bar[XB_XSUB(b.x)], 1u);
    const unsigned gen = old / nloc;
    if (old + 1u == (gen + 1u) * nloc) {
      __builtin_amdgcn_fence(__ATOMIC_RELEASE, "agent");
      asm volatile("s_waitcnt vmcnt(0)" ::: "memory");
      const unsigned og = xb_add(&bar[XB_TOP], 1u);
      const unsigned tg = og / nx;
      if (og + 1u == (tg + 1u) * nx) xb_add(&bar[XB_TOPGEN], 1u);
      else XB_SPIN(xb_ld(&bar[XB_TOPGEN]) == tg, bar);
      __builtin_amdgcn_fence(__ATOMIC_ACQUIRE, "agent");
      xb_add(&bar[XB_XGEN(b.x)], 1u);
      asm volatile("s_waitcnt vmcnt(0)" ::: "memory");
    } else {
      XB_SPIN(xb_ld(&bar[XB_XGEN(b.x)]) == gen, bar);
      __builtin_amdgcn_fence(__ATOMIC_ACQUIRE, "agent");
      asm volatile("s_waitcnt vmcnt(0)" ::: "memory");
    }
  }
  __syncthreads();
}

__global__ void __launch_bounds__(NTHREADS) k_mega(Params P) {
  extern __shared__ __attribute__((aligned(16))) char lds_raw[];
  LAS char* lds = (LAS char*)lds_raw;
  if (threadIdx.x < 4) ((LAS unsigned*)(lds + LDS_BAR))[threadIdx.x] = 0u;
  __syncthreads();
  const XcdBarrier bar = xcd_barrier_post((unsigned*)(P.ws + OFF_BAR), (volatile LAS unsigned*)(lds + LDS_BAR));
  if (threadIdx.x == 0) ((LAS unsigned*)(lds + LDS_BAR))[2] = xb_add((unsigned*)(P.ws + OFF_CNT + 2048) + 16 * bar.x, 1u);
  phase_pack(P);
  xcd_barrier(bar);
  for (int tile = blockIdx.x; tile < NTILES; tile += gridDim.x) phase_z_tile(P, lds, tile);
  xcd_barrier(bar);
  {
    const int ustride = gridDim.x * NTHREADS;
    int pack_base = 0;
    for (int tile = blockIdx.x; tile < NTILES; tile += gridDim.x) { phase_m_tile(P, lds, tile, pack_base); pack_base += 24 * ustride; }
    for (int u = pack_base + blockIdx.x * NTHREADS + threadIdx.x; u < PACK_UNITS; u += 3 * ustride) {
      float pv[3][8];
      pack_issue(P, u, ustride, pv);
      pack_commit(P, u, ustride, pv);
    }
  }
  xcd_barrier(bar);
  phase_f(P, lds, bar.x, ((LAS unsigned*)(lds + LDS_BAR))[2]);
  xcd_barrier(bar);
  for (int tile = blockIdx.x; tile < NTILES; tile += gridDim.x) phase_l_tile(P, lds, tile);
}
}

static Params make_params(void* const* d_in, void* d_out, void* d_ws) {
  Params P{};
  const float** f = (const float**)&P;
  for (int i = 0; i < 25; ++i) f[i] = (const float*)d_in[i];
  P.out = (float*)d_out;
  P.ws = (char*)d_ws;
  return P;
}

extern "C" void kernel_launch(void* const* d_in, const int* in_sizes, int n_in, void* d_out, int out_size, void* d_ws, size_t ws_size, hipStream_t stream) {
  static int grid = 0;
  if (grid == 0) {
    if (ws_size < OFF_END || n_in != 25) { fprintf(stderr, "kernel_launch: bad ws/n_in: %zu < %zu, n_in %d\n", ws_size, (size_t)OFF_END, n_in); grid = -1; return; }
    int dev = 0, cus = 0, per_cu = 0;
    (void)hipGetDevice(&dev);
    (void)hipDeviceGetAttribute(&cus, hipDeviceAttributeMultiprocessorCount, dev);
    (void)hipFuncSetAttribute((const void*)k_mega, hipFuncAttributeMaxDynamicSharedMemorySize, LDS_BYTES);
    (void)hipOccupancyMaxActiveBlocksPerMultiprocessor(&per_cu, (const void*)k_mega, NTHREADS, LDS_BYTES);
    if (per_cu < 1) { fprintf(stderr, "kernel_launch: occupancy query says %d blocks/CU\n", per_cu); }
    (void)hipGetLastError();
    grid = cus;
  }
  if (grid < 0) return;
  (void)hipMemsetAsync(d_ws, 0, CTRL_BYTES, stream);
  Params P = make_params(d_in, d_out, d_ws);
  void* args[] = {&P};
  hipError_t e = hipLaunchCooperativeKernel((const void*)k_mega, dim3(grid), dim3(NTHREADS), args, LDS_BYTES, stream);
  if (e != hipSuccess) fprintf(stderr, "kernel_launch: cooperative launch failed: %s (grid %d)\n", hipGetErrorString(e), grid);
}
```

```cpp
#include <hip/hip_runtime.h>
#include <hip/hip_fp16.h>
#include <cstdio>
#include <cstdint>

namespace {
constexpr int T = 32768, SEQ = 8192, D = 1024, DIN = 1536, DPOOL = 512, DCONV = 512, DEXP = 512, DPLE = 256;
constexpr int NEXP = 32, CW = 31;
constexpr float ALPHA = 1.189207115002721f;
constexpr float EPS = 1e-5f;
constexpr int NTHREADS = 512;
constexpr int NTILES = T / 64;
constexpr int XS = 1032;

constexpr int LDS_TILE = 0;
constexpr int LDS_AUX = 64 * XS * 2;
constexpr int LDS_RED = LDS_AUX + 25600;
constexpr int LDS_BAR = LDS_RED + 4096;
constexpr int LDS_BYTES = LDS_BAR + 16;
typedef _Float16 half8 __attribute__((ext_vector_type(8)));
typedef _Float16 half4 __attribute__((ext_vector_type(4)));
typedef _Float16 half2v __attribute__((ext_vector_type(2)));
typedef float f32x16 __attribute__((ext_vector_type(16)));
#define LAS __attribute__((address_space(3)))
#define MFMA(a, b, c) __builtin_amdgcn_mfma_f32_32x32x16_f16((a), (b), (c), 0, 0, 0)

constexpr size_t OFF_BAR  = 0;
constexpr size_t OFF_CNT  = 16384;
constexpr size_t CTRL_BYTES = 20480;
constexpr size_t OFF_LIST = CTRL_BYTES;
constexpr size_t OFF_WGT  = OFF_LIST + (size_t)NEXP * T * 4;
constexpr size_t OFF_WIN  = OFF_WGT + (size_t)2 * T * 4;
constexpr size_t OFF_WOUT = OFF_WIN + (size_t)DIN * D * 2;
constexpr size_t OFF_WR   = OFF_WOUT + (size_t)D * D * 2;
constexpr size_t OFF_WG   = OFF_WR + (size_t)64 * D * 2;
constexpr size_t OFF_WU   = OFF_WG + (size_t)NEXP * D * DEXP * 2;
constexpr size_t OFF_WD   = OFF_WU + (size_t)NEXP * D * DEXP * 2;
constexpr size_t OFF_WPP  = OFF_WD + (size_t)NEXP * D * DEXP * 2;
constexpr size_t OFF_WPG  = OFF_WPP + (size_t)DPLE * D * 2;
constexpr size_t OFF_Z    = OFF_WPG + (size_t)D * D * 2;
constexpr size_t OFF_CC   = OFF_Z + (size_t)T * DIN * 2;
constexpr size_t OFF_H    = OFF_CC + (size_t)T * D * 2;
constexpr size_t OFF_YB   = OFF_H + (size_t)T * D * 2;
constexpr size_t OFF_END  = OFF_YB + (size_t)2 * T * D * 2;

struct Params {
  const float *x, *p, *w_in, *w_pool_mix, *pool_scale, *w_dw, *b_dw, *conv_ln_g, *conv_ln_b, *w_out, *ln1_g, *ln1_b, *w_coarse, *b_coarse, *w_fine,
      *b_fine, *w_gate, *w_up, *w_down, *ln2_g, *ln2_b, *w_ple_proj, *w_ple_gate, *ln3_g, *ln3_b;
  float* out;
  char* ws;
};

__device__ __forceinline__ float sigmoidf_(float x) { return __builtin_amdgcn_rcpf(1.f + __expf(-x)); }
__device__ __forceinline__ float siluf_(float x) { return x * __builtin_amdgcn_rcpf(1.f + __expf(-x)); }

template <class F>
__device__ __forceinline__ void pack_mat(_Float16* __restrict__ dst, const int NB, const int K, const int N, F src, const int gtid, const int gth) {
  const int KT = K / 16, MT = N / 32;
  const int total = NB * MT * KT * 64;
  for (int idx = gtid; idx < total; idx += gth) {
    const int lane = idx & 63;
    int f = idx >> 6;
    const int kt = f % KT; f /= KT;
    const int mt = f % MT; const int b = f / MT;
    const int k0 = kt * 16 + (lane >> 5) * 8, n = mt * 32 + (lane & 31);
    half8 v;
#pragma unroll
    for (int j = 0; j < 8; ++j) v[j] = (_Float16)src(b, k0 + j, n);
    *(half8*)(dst + (size_t)idx * 8) = v;
  }
}

__device__ void phase_pack(const Params& P) {
  const int gtid = blockIdx.x * NTHREADS + threadIdx.x, gth = gridDim.x * NTHREADS;
  char* ws = P.ws;
  {
    _Float16* dst = (_Float16*)(ws + OFF_WIN);
    const int total = 48 * 64 * 64;
    for (int idx = gtid; idx < total; idx += gth) {
      const int lane = idx & 63;
      const int f = idx >> 6;
      const int kt = f & 63, mt = f >> 6;
      const int k0 = kt * 16 + (lane >> 5) * 8, n = mt * 32 + (lane & 31);
      half8 v;
      if (mt >= 16) {
#pragma unroll
        for (int j = 0; j < 8; ++j) v[j] = (_Float16)P.w_in[(size_t)(k0 + j) * DIN + n];
      } else {
        const int g = n >> 7, d = n & 127;
        float acc[8];
#pragma unroll
        for (int j = 0; j < 8; ++j) acc[j] = 0.f;
        const float* wpm = P.w_pool_mix + (size_t)g * 128 * 128 + d;
        const float* wi = P.w_in + (size_t)k0 * DIN + g * 128;
        for (int c = 0; c < 128; ++c) {
          const float m = wpm[c * 128];
#pragma unroll
          for (int j = 0; j < 8; ++j) acc[j] = fmaf(wi[(size_t)j * DIN + c], m, acc[j]);
        }
        const float sc = P.pool_scale[n];
#pragma unroll
        for (int j = 0; j < 8; ++j) v[j] = (_Float16)(acc[j] * sc);
      }
      *(half8*)(dst + (size_t)idx * 8) = v;
    }
  }
  pack_mat((_Float16*)(ws + OFF_WOUT), 1, D, D, [&](int, int k, int n) { return P.w_out[(size_t)k * D + n]; }, gtid, gth);
  pack_mat((_Float16*)(ws + OFF_WR), 1, D, 64, [&](int, int k, int n) { return n < 4 ? P.w_coarse[k * 4 + n] : (n < 36 ? P.w_fine[k * 32 + n - 4] : 0.f); }, gtid, gth);
  pack_mat((_Float16*)(ws + OFF_WPP), 1, DPLE, D, [&](int, int k, int n) { return P.w_ple_proj[(size_t)k * D + n]; }, gtid, gth);
  pack_mat((_Float16*)(ws + OFF_WPG), 1, D, D, [&](int, int k, int n) { return P.w_ple_gate[(size_t)k * D + n]; }, gtid, gth);
}

template <int NA, int PF>
__device__ __forceinline__ void gemm_core(const _Float16* const (&ab)[NA], const int lane_off, const int KT,
                                          const LAS _Float16* bp, const int nt_stride, f32x16 (&acc)[NA][2]) {
  half8 abuf[PF][NA];
#pragma unroll
  for (int s = 0; s < PF; ++s)
#pragma unroll
    for (int i = 0; i < NA; ++i) abuf[s][i] = *(const half8*)(ab[i] + s * 512 + lane_off);
  half8 bb[2][2];
  bb[0][0] = *(const LAS half8*)(bp);
  bb[0][1] = *(const LAS half8*)(bp + nt_stride);
#pragma unroll 1
  for (int kt = 0; kt < KT; kt += PF) {
#pragma unroll
    for (int s = 0; s < PF; ++s) {
      const int k = kt + s;
      const int kb = (k + 1 < KT) ? (k + 1) : (KT - 1);
      bb[(s + 1) & 1][0] = *(const LAS half8*)(bp + kb * 16);
      bb[(s + 1) & 1][1] = *(const LAS half8*)(bp + nt_stride + kb * 16);
      __builtin_amdgcn_sched_barrier(0);
#pragma unroll
      for (int i = 0; i < NA; ++i) {
        acc[i][0] = MFMA(abuf[s][i], bb[s & 1][0], acc[i][0]);
        acc[i][1] = MFMA(abuf[s][i], bb[s & 1][1], acc[i][1]);
      }
      const int kn = (k + PF < KT) ? (k + PF) : (KT - 1);
#pragma unroll
      for (int i = 0; i < NA; ++i) abuf[s][i] = *(const half8*)(ab[i] + kn * 512 + lane_off);
      __builtin_amdgcn_sched_barrier(0);
    }
  }
}

template <int NA>
__device__ __forceinline__ void zero_acc(f32x16 (&acc)[NA][2]) {
#pragma unroll
  for (int i = 0; i < NA; ++i)
#pragma unroll
    for (int n = 0; n < 2; ++n)
#pragma unroll
      for (int r = 0; r < 16; ++r) acc[i][n][r] = 0.f;
}

__device__ void phase_z_tile(const Params& P, LAS char* lds, const int tile) {
  const int tid = threadIdx.x, lane = tid & 63, wave = __builtin_amdgcn_readfirstlane(tid >> 6);
  const int r = lane & 31, hh = lane >> 5;
  LAS _Float16* xt = (LAS _Float16*)lds;
  const int t0 = tile * 64;
#pragma unroll 8
  for (int it = 0; it < 32; ++it) {
    const int idx = tid + it * NTHREADS;
    const int row = idx >> 8, c4 = idx & 255;
    const float4 v = *(const float4*)(P.x + (size_t)(t0 + row) * D + c4 * 4);
    half4 hv = {(_Float16)v.x, (_Float16)v.y, (_Float16)v.z, (_Float16)v.w};
    *(LAS half4*)(xt + row * XS + c4 * 4) = hv;
  }
  __syncthreads();
  const _Float16* wp = (const _Float16*)(P.ws + OFF_WIN);
  _Float16* zN = (_Float16*)(P.ws + OFF_Z);
  const LAS _Float16* bp = xt + r * XS + hh * 8;
#pragma unroll 1
  for (int pass = 0; pass < 2; ++pass) {
    f32x16 acc[3][2];
    zero_acc<3>(acc);
    const int mt0 = pass * 24 + wave * 3;
    const _Float16* const ab[3] = {wp + (size_t)mt0 * 64 * 512, wp + (size_t)(mt0 + 1) * 64 * 512, wp + (size_t)(mt0 + 2) * 64 * 512};
    gemm_core<3, 4>(ab, lane * 8, 64, bp, 32 * XS, acc);
#pragma unroll
    for (int i = 0; i < 3; ++i)
#pragma unroll
      for (int nt = 0; nt < 2; ++nt)
#pragma unroll
        for (int q = 0; q < 4; ++q) {
          half4 hv = {(_Float16)acc[i][nt][4 * q], (_Float16)acc[i][nt][4 * q + 1], (_Float16)acc[i][nt][4 * q + 2], (_Float16)acc[i][nt][4 * q + 3]};
          const size_t off = ((((size_t)tile * 48 + (mt0 + i)) * 2 + nt) * 4 + q) * 256 + lane * 4;
          *(half4*)(zN + off) = hv;
        }
  }
  __syncthreads();
}


__device__ __forceinline__ void ln_stats(const f32x16 (&v)[4][2], LAS float* red, const int wave, const int lane, float (&mu)[2], float (&rs)[2]) {
  const int r = lane & 31, hh = lane >> 5;
#pragma unroll
  for (int nt = 0; nt < 2; ++nt) {
    float s = 0.f, ss = 0.f;
#pragma unroll
    for (int i = 0; i < 4; ++i)
#pragma unroll
      for (int g = 0; g < 16; ++g) { const float x = v[i][nt][g]; s += x; ss = fmaf(x, x, ss); }
    s += __shfl_xor(s, 32);
    ss += __shfl_xor(ss, 32);
    if (hh == 0) { red[(wave * 64 + nt * 32 + r) * 2] = s; red[(wave * 64 + nt * 32 + r) * 2 + 1] = ss; }
  }
  __syncthreads();
#pragma unroll
  for (int nt = 0; nt < 2; ++nt) {
    float s = 0.f, ss = 0.f;
#pragma unroll
    for (int w = 0; w < 8; ++w) { s += red[(w * 64 + nt * 32 + r) * 2]; ss += red[(w * 64 + nt * 32 + r) * 2 + 1]; }
    const float m = s * (1.f / D);
    const float var = fmaxf(ss * (1.f / D) - m * m, 0.f);
    mu[nt] = m;
    rs[nt] = rsqrtf(var + EPS);
  }
}


constexpr int PACK_UNITS = 3 << 21;
__device__ __forceinline__ void pack_issue(const Params& P, const int u0, const int ustride, float (&pv)[3][8]) {
#pragma unroll
  for (int q = 0; q < 3; ++q) {
    const int u = u0 + q * ustride;
    if (u < PACK_UNITS) {
      const int m = u >> 21, idx = u & ((1 << 21) - 1), lane = idx & 63, f = idx >> 6, e = f >> 10;
      const int r = lane & 31, hh = lane >> 5;
      const float* src;
      int stride;
      if (m < 2) {
        const int kt = f & 63, mt = (f >> 6) & 15;
        src = (m == 0 ? P.w_gate : P.w_up) + ((size_t)e * D + kt * 16 + hh * 8) * DEXP + mt * 32 + r;
        stride = DEXP;
      } else {
        const int kt = f & 31, mt = (f >> 5) & 31;
        src = P.w_down + ((size_t)e * DEXP + kt * 16 + hh * 8) * D + mt * 32 + r;
        stride = D;
      }
#pragma unroll
      for (int j = 0; j < 8; ++j) pv[q][j] = src[(size_t)j * stride];
    }
  }
}
__device__ __forceinline__ void pack_commit(const Params& P, const int u0, const int ustride, const float (&pv)[3][8]) {
#pragma unroll
  for (int q = 0; q < 3; ++q) {
    const int u = u0 + q * ustride;
    if (u < PACK_UNITS) {
      half8 v;
#pragma unroll
      for (int j = 0; j < 8; ++j) v[j] = (_Float16)pv[q][j];
      *(half8*)((_Float16*)(P.ws + OFF_WG) + (size_t)u * 8) = v;
    }
  }
}
constexpr int RS = 100;
constexpr int WST_BYTES = 16 * RS * 2;
__device__ __forceinline__ void fill_issue_w(const _Float16* __restrict__ zN, const int tile, const int g, const bool has_prev, const int wave, const int lane,
                                             half4 (&za)[6], half4 (&zb)[6]) {
  const bool glu = g >= 4;
  const int mtl = (glu ? 16 + (g - 4) * 4 : g * 4) + (wave >> 1), q0 = (wave & 1) * 2;
#pragma unroll
  for (int uu = 0; uu < 6; ++uu) {
    const int st = uu >> 1, q = q0 + (uu & 1);
    const int ztile = (st == 0) ? tile - 1 : tile;
    const int nt = (st == 0) ? 1 : st - 1;
    const half4 z0 = {(_Float16)0.f, (_Float16)0.f, (_Float16)0.f, (_Float16)0.f};
    za[uu] = z0; zb[uu] = z0;
    if (st != 0 || has_prev) {
      const size_t off = ((((size_t)ztile * 48 + mtl) * 2 + nt) * 4 + q) * 256 + lane * 4;
      za[uu] = *(const half4*)(zN + off);
      if (glu) zb[uu] = *(const half4*)(zN + off + (size_t)16 * 2 * 4 * 256);
    }
  }
}
__device__ __forceinline__ void fill_commit_w(LAS _Float16* wst, const bool glu, const int lane, const half4 (&za)[6], const half4 (&zb)[6]) {
  const int r = lane & 31, hh = lane >> 5;
#pragma unroll
  for (int uu = 0; uu < 6; ++uu) {
    const int st = uu >> 1, qq = uu & 1;
#pragma unroll
    for (int e = 0; e < 4; ++e) {
      float v = (float)za[uu][e];
      if (glu) v *= sigmoidf_((float)zb[uu][e]);
      wst[(qq * 8 + hh * 4 + e) * RS + st * 32 + r] = (_Float16)v;
    }
  }
}
__device__ __forceinline__ float seg16_treduce(const float (&v)[16]) {
  const int lane = threadIdx.x & 63;
  float a8[8], a4[4], a2[2];
  {
    const bool up = (lane & 8) != 0;
#pragma unroll
    for (int i = 0; i < 8; ++i) { const float keep = up ? v[i + 8] : v[i], send = up ? v[i] : v[i + 8]; a8[i] = keep + __shfl_xor(send, 8); }
  }
  {
    const bool up = (lane & 4) != 0;
#pragma unroll
    for (int i = 0; i < 4; ++i) { const float keep = up ? a8[i + 4] : a8[i], send = up ? a8[i] : a8[i + 4]; a4[i] = keep + __shfl_xor(send, 4); }
  }
  {
    const bool up = (lane & 2) != 0;
#pragma unroll
    for (int i = 0; i < 2; ++i) { const float keep = up ? a4[i + 2] : a4[i], send = up ? a4[i] : a4[i + 2]; a2[i] = keep + __shfl_xor(send, 2); }
  }
  const bool up = (lane & 1) != 0;
  const float keep = up ? a2[1] : a2[0], send = up ? a2[0] : a2[1];
  return keep + __shfl_xor(send, 1);
}
template <int W>
__device__ __forceinline__ void pool_group_w(const LAS _Float16* wst, LAS _Float16* cc, const int g, const int s0, const int wave, const int lane) {
  const int c = lane & 15, tg = lane >> 4;
  float v[32];
#pragma unroll
  for (int i = 0; i < 16; ++i) {
    const half2v p = *(const LAS half2v*)(wst + c * RS + 16 + tg * 16 + 2 * i);
    v[2 * i] = (float)p[0]; v[2 * i + 1] = (float)p[1];
  }
  float S = 0.f;
#pragma unroll
  for (int i = 0; i < W; ++i) S += v[16 - i];
#pragma unroll
  for (int j = 0; j < 16; ++j) {
    if (j > 0) S += v[16 + j] - v[16 + j - W];
    const int s = s0 + tg * 16 + j;
    const int cnt = (s + 1 < W) ? (s + 1) : W;
    const float o = S * __builtin_amdgcn_rcpf((float)cnt) - v[16 + j];
    cc[(tg * 16 + j) * XS + g * 128 + wave * 16 + c] = (_Float16)o;
  }
}

__device__ void phase_m_tile(const Params& P, LAS char* lds, const int tile, const int pack_base) {
  int tid_ = threadIdx.x;
  asm volatile("" : "+v"(tid_));
  const int tid = tid_, lane = tid & 63, wave = __builtin_amdgcn_readfirstlane(tid >> 6);
  const int r = lane & 31, hh = lane >> 5;
  const int t0 = tile * 64;
  const int s0 = t0 % SEQ;
  const bool has_prev = (s0 != 0);
  const _Float16* zN = (const _Float16*)(P.ws + OFF_Z);
  LAS _Float16* cc = (LAS _Float16*)(lds + LDS_TILE);
  LAS _Float16* ub = (LAS _Float16*)(lds + LDS_AUX);
  LAS float* red = (LAS float*)(lds + LDS_RED);

  const int ustride = gridDim.x * NTHREADS;
  int pu = pack_base + blockIdx.x * NTHREADS + tid;
  LAS _Float16* wst = (LAS _Float16*)(lds + LDS_AUX + wave * WST_BYTES);
  const int c16 = lane & 15, tg = lane >> 4;
  half4 za[6], zb[6];
  fill_issue_w(zN, tile, 0, has_prev, wave, lane, za, zb);
#pragma unroll 1
  for (int g = 0; g < 8; ++g) {
    const bool glu = g >= 4;
    const int hd = g - 4, ch = (glu ? hd : 0) * 128 + wave * 16 + c16;
    fill_commit_w(wst, glu, lane, za, zb);
    if (g < 7) fill_issue_w(zN, tile, g + 1, has_prev, wave, lane, za, zb);
    float wv[CW];
    float bias = 0.f, g_ = 0.f, b_ = 0.f;
    if (glu) {
#pragma unroll
      for (int jj = 0; jj < CW; ++jj) wv[jj] = P.w_dw[jj * DCONV + ch];
      bias = P.b_dw[ch]; g_ = P.conv_ln_g[ch]; b_ = P.conv_ln_b[ch];
    } else {
#pragma unroll
      for (int jj = 0; jj < CW; ++jj) wv[jj] = 0.f;
    }
    float pv[3][8];
    pack_issue(P, pu, ustride, pv);
    if (!glu) {
      if (g == 0) pool_group_w<2>(wst, cc, 0, s0, wave, lane);
      else if (g == 1) pool_group_w<4>(wst, cc, 1, s0, wave, lane);
      else if (g == 2) pool_group_w<8>(wst, cc, 2, s0, wave, lane);
      else pool_group_w<16>(wst, cc, 3, s0, wave, lane);
    } else {
      float y[16];
      {
        float uv[46];
#pragma unroll
        for (int i = 0; i < 23; ++i) {
          const half2v p = *(const LAS half2v*)(wst + c16 * RS + tg * 16 + 2 + 2 * i);
          uv[2 * i] = (float)p[0]; uv[2 * i + 1] = (float)p[1];
        }
#pragma unroll
        for (int j = 0; j < 16; ++j) y[j] = bias;
#pragma unroll
        for (int jj = 0; jj < CW; ++jj) {
#pragma unroll
          for (int j = 0; j < 16; ++j) y[j] = fmaf(wv[jj], uv[j + jj], y[j]);
        }
      }
      float t1, t2;
      {
        float sq[16];
#pragma unroll
        for (int j = 0; j < 16; ++j) sq[j] = y[j] * y[j];
        t1 = seg16_treduce(y);
        t2 = seg16_treduce(sq);
      }
      __syncthreads();
      red[(wave * 64 + lane) * 2] = t1;
      red[(wave * 64 + lane) * 2 + 1] = t2;
      __syncthreads();
      float s1 = 0.f, s2 = 0.f;
#pragma unroll
      for (int w = 0; w < 8; ++w) { s1 += red[(w * 64 + lane) * 2]; s2 += red[(w * 64 + lane) * 2 + 1]; }
      const float m_l = s1 * (1.f / 128.f);
      const float r_l = rsqrtf(fmaxf(s2 * (1.f / 128.f) - m_l * m_l, 0.f) + EPS);
#pragma unroll
      for (int j = 0; j < 16; ++j) {
        const float m = __shfl(m_l, tg * 16 + j), rsd = __shfl(r_l, tg * 16 + j);
        const float v = (y[j] - m) * rsd * g_ + b_;
        cc[(tg * 16 + j) * XS + 512 + ch] = (_Float16)siluf_(v);
      }
    }
    pack_commit(P, pu, ustride, pv);
    pu += 3 * ustride;
  }
  __syncthreads();

  f32x16 acc[4][2];
  zero_acc<4>(acc);
  {
    const _Float16* wp = (const _Float16*)(P.ws + OFF_WOUT) + (size_t)(wave * 4) * 64 * 512;
    const _Float16* const ab[4] = {wp, wp + 64 * 512, wp + 2 * 64 * 512, wp + 3 * 64 * 512};
    gemm_core<4, 4>(ab, lane * 8, 64, cc + r * XS + hh * 8, 32 * XS, acc);
  }
#pragma unroll
  for (int i = 0; i < 4; ++i)
#pragma unroll
    for (int nt = 0; nt < 2; ++nt)
#pragma unroll
      for (int q = 0; q < 4; ++q) {
        const int ch0 = (wave * 4 + i) * 32 + q * 8 + hh * 4;
        const float4 xv = *(const float4*)(P.x + (size_t)(t0 + nt * 32 + r) * D + ch0);
        acc[i][nt][4 * q + 0] = fmaf(ALPHA, xv.x, acc[i][nt][4 * q + 0]);
        acc[i][nt][4 * q + 1] = fmaf(ALPHA, xv.y, acc[i][nt][4 * q + 1]);
        acc[i][nt][4 * q + 2] = fmaf(ALPHA, xv.z, acc[i][nt][4 * q + 2]);
        acc[i][nt][4 * q + 3] = fmaf(ALPHA, xv.w, acc[i][nt][4 * q + 3]);
      }
  float mu[2], rs[2];
  ln_stats(acc, red, wave, lane, mu, rs);
#pragma unroll
  for (int i = 0; i < 4; ++i)
#pragma unroll
    for (int q = 0; q < 4; ++q) {
      const int ch0 = (wave * 4 + i) * 32 + q * 8 + hh * 4;
      const float4 gv = *(const float4*)(P.ln1_g + ch0), bv = *(const float4*)(P.ln1_b + ch0);
#pragma unroll
      for (int nt = 0; nt < 2; ++nt) {
        half4 hv;
        hv[0] = (_Float16)((acc[i][nt][4 * q + 0] - mu[nt]) * rs[nt] * gv.x + bv.x);
        hv[1] = (_Float16)((acc[i][nt][4 * q + 1] - mu[nt]) * rs[nt] * gv.y + bv.y);
        hv[2] = (_Float16)((acc[i][nt][4 * q + 2] - mu[nt]) * rs[nt] * gv.z + bv.z);
        hv[3] = (_Float16)((acc[i][nt][4 * q + 3] - mu[nt]) * rs[nt] * gv.w + bv.w);
        *(LAS half4*)(cc + (nt * 32 + r) * XS + ch0) = hv;
      }
    }
  __syncthreads();
  LAS int* hist = (LAS int*)(lds + LDS_RED);
  if (tid < 64) hist[tid] = 0;
  {
    _Float16* hb = (_Float16*)(P.ws + OFF_H);
#pragma unroll 4
    for (int it = 0; it < 16; ++it) {
      const int idx = tid + it * NTHREADS;
      const int row = idx >> 7, ck = idx & 127;
      const half8 v = *(const LAS half8*)(cc + row * XS + ck * 8);
      *(half8*)(hb + (size_t)(t0 + row) * D + ck * 8) = v;
    }
  }
  LAS float* lg = (LAS float*)(lds + LDS_AUX);
  {
    const int ct = wave & 1, nt = (wave >> 1) & 1, kh = wave >> 2;
    f32x16 ra;
#pragma unroll
    for (int g = 0; g < 16; ++g) ra[g] = 0.f;
    const _Float16* ap = (const _Float16*)(P.ws + OFF_WR) + ((size_t)ct * 64 + kh * 32) * 512 + lane * 8;
    const LAS _Float16* bp = cc + (nt * 32 + r) * XS + kh * 512 + hh * 8;
#pragma unroll 4
    for (int kt = 0; kt < 32; ++kt) {
      const half8 a = *(const half8*)(ap + kt * 512);
      const half8 b = *(const LAS half8*)(bp + kt * 16);
      ra = MFMA(a, b, ra);
    }
    if (kh == 1) {
#pragma unroll
      for (int g = 0; g < 16; ++g) lg[(ct * 32 + (g & 3) + 8 * (g >> 2) + 4 * hh) * 64 + nt * 32 + r] = ra[g];
    }
    __syncthreads();
    if (kh == 0) {
#pragma unroll
      for (int g = 0; g < 16; ++g) lg[(ct * 32 + (g & 3) + 8 * (g >> 2) + 4 * hh) * 64 + nt * 32 + r] += ra[g];
    }
    __syncthreads();
  }
  int ex1 = 0, ex2 = 0, rk1 = 0, rk2 = 0;
  float wt1 = 0.f, wt2 = 0.f;
  if (tid < 64) {
    float lc[4];
#pragma unroll
    for (int i = 0; i < 4; ++i) lc[i] = lg[i * 64 + tid] + P.b_coarse[i];
    int g = 0; float mx = lc[0];
#pragma unroll
    for (int i = 1; i < 4; ++i) if (lc[i] > mx) { mx = lc[i]; g = i; }
    float den = 0.f;
#pragma unroll
    for (int i = 0; i < 4; ++i) den += __expf(lc[i] - mx);
    const float pg = 1.f / den;
    float sel[8];
#pragma unroll
    for (int i = 0; i < 8; ++i) sel[i] = lg[(4 + g * 8 + i) * 64 + tid] + P.b_fine[g * 8 + i];
    int e1 = 0; float m1 = sel[0];
#pragma unroll
    for (int i = 1; i < 8; ++i) if (sel[i] > m1) { m1 = sel[i]; e1 = i; }
    int e2 = -1; float m2 = -3.0e38f;
#pragma unroll
    for (int i = 0; i < 8; ++i) if (i != e1 && sel[i] > m2) { m2 = sel[i]; e2 = i; }
    const float q2 = __expf(m2 - m1);
    wt1 = pg / (1.f + q2);
    wt2 = pg * q2 / (1.f + q2);
    ex1 = g * 8 + e1; ex2 = g * 8 + e2;
    rk1 = atomicAdd((int*)&hist[ex1], 1);
    rk2 = atomicAdd((int*)&hist[ex2], 1);
  }
  __syncthreads();
  if (tid < 32) {
    const int n = hist[tid];
    int base = 0;
    if (n > 0) base = atomicAdd((int*)(P.ws + OFF_CNT) + tid, n);
    hist[32 + tid] = base;
  }
  __syncthreads();
  if (tid < 64) {
    int* list = (int*)(P.ws + OFF_LIST);
    float* wgt = (float*)(P.ws + OFF_WGT);
    const int t = t0 + tid;
    list[(size_t)ex1 * T + hist[32 + ex1] + rk1] = t * 2;
    list[(size_t)ex2 * T + hist[32 + ex2] + rk2] = t * 2 + 1;
    wgt[t * 2] = wt1;
    wgt[t * 2 + 1] = wt2;
  }
  __syncthreads();
}

constexpr int AS = 520;
__device__ void phase_f_tile(const Params& P, LAS char* lds, const int e, const int row0, const int nrows) {
  int tid_ = threadIdx.x;
  asm volatile("" : "+v"(tid_));
  const int tid = tid_, lane = tid & 63, wave = __builtin_amdgcn_readfirstlane(tid >> 6);
  const int r = lane & 31, hh = lane >> 5;
  LAS _Float16* cc = (LAS _Float16*)(lds + LDS_TILE);
  LAS int* la = (LAS int*)(lds + LDS_RED + 256);
  LAS float* lw = (LAS float*)(lds + LDS_RED + 512);
  if (tid < 64) {
    int a = -1; float w = 0.f;
    if (tid < nrows) { a = ((const int*)(P.ws + OFF_LIST))[(size_t)e * T + row0 + tid]; w = ((const float*)(P.ws + OFF_WGT))[a]; }
    la[tid] = a; lw[tid] = w;
  }
  __syncthreads();
  {
    const _Float16* hb = (const _Float16*)(P.ws + OFF_H);
#pragma unroll 4
    for (int it = 0; it < 16; ++it) {
      const int idx = tid + it * NTHREADS;
      const int row = idx >> 7, ck = idx & 127;
      const int a = la[row];
      half8 v = {(_Float16)0.f, (_Float16)0.f, (_Float16)0.f, (_Float16)0.f, (_Float16)0.f, (_Float16)0.f, (_Float16)0.f, (_Float16)0.f};
      if (a >= 0) v = *(const half8*)(hb + (size_t)(a >> 1) * D + ck * 8);
      *(LAS half8*)(cc + row * XS + ck * 8) = v;
    }
  }
  __syncthreads();
  f32x16 acc[4][2];
  zero_acc<4>(acc);
  {
    const _Float16* wg = (const _Float16*)(P.ws + OFF_WG) + (size_t)(e * 16 + wave * 2) * 64 * 512;
    const _Float16* wu = (const _Float16*)(P.ws + OFF_WU) + (size_t)(e * 16 + wave * 2) * 64 * 512;
    const _Float16* const ab[4] = {wg, wg + 64 * 512, wu, wu + 64 * 512};
    gemm_core<4, 4>(ab, lane * 8, 64, cc + r * XS + hh * 8, 32 * XS, acc);
  }
  __syncthreads();
  LAS _Float16* at = (LAS _Float16*)(lds + LDS_TILE);
#pragma unroll
  for (int i = 0; i < 2; ++i)
#pragma unroll
    for (int nt = 0; nt < 2; ++nt)
#pragma unroll
      for (int q = 0; q < 4; ++q) {
        half4 hv;
#pragma unroll
        for (int j = 0; j < 4; ++j) hv[j] = (_Float16)(siluf_(acc[i][nt][4 * q + j]) * acc[i + 2][nt][4 * q + j]);
        *(LAS half4*)(at + (nt * 32 + r) * AS + wave * 64 + i * 32 + q * 8 + hh * 4) = hv;
      }
  __syncthreads();
  zero_acc<4>(acc);
  {
    const _Float16* wd = (const _Float16*)(P.ws + OFF_WD) + (size_t)(e * 32 + wave * 4) * 32 * 512;
    const _Float16* const ab[4] = {wd, wd + 32 * 512, wd + 2 * 32 * 512, wd + 3 * 32 * 512};
    gemm_core<4, 4>(ab, lane * 8, 32, at + r * AS + hh * 8, 32 * AS, acc);
  }
  __syncthreads();
  {
    const float w0 = lw[r], w1 = lw[32 + r];
#pragma unroll
    for (int i = 0; i < 4; ++i)
#pragma unroll
      for (int nt = 0; nt < 2; ++nt)
#pragma unroll
        for (int q = 0; q < 4; ++q) {
          const float w = nt ? w1 : w0;
          half4 hv;
#pragma unroll
          for (int j = 0; j < 4; ++j) hv[j] = (_Float16)(acc[i][nt][4 * q + j] * w);
          *(LAS half4*)(cc + (nt * 32 + r) * XS + (wave * 4 + i) * 32 + q * 8 + hh * 4) = hv;
        }
  }
  __syncthreads();
  {
    _Float16* yb = (_Float16*)(P.ws + OFF_YB);
#pragma unroll 4
    for (int it = 0; it < 16; ++it) {
      const int idx = tid + it * NTHREADS;
      const int row = idx >> 7, ck = idx & 127;
      const int a = la[row];
      if (a >= 0) *(half8*)(yb + (size_t)a * D + ck * 8) = *(const LAS half8*)(cc + row * XS + ck * 8);
    }
  }
  __syncthreads();
}

__device__ void phase_f(const Params& P, LAS char* lds, const unsigned xcc, const unsigned xrank) {
  LAS int* sm = (LAS int*)(lds + LDS_RED);
  const int* counts = (const int*)(P.ws + OFF_CNT);
  if (threadIdx.x == 0) {
    int a = 0;
    for (int e = 0; e < NEXP; ++e) { sm[e] = a; a += (counts[e] + 63) >> 6; }
    sm[32] = a;
  }
  __syncthreads();
  const int total = sm[32];
  int vb = 0;
  for (unsigned x = 0; x < xcc; ++x) vb += (int)__hip_atomic_load((unsigned*)(P.ws + OFF_CNT + 2048) + 16 * x, __ATOMIC_RELAXED, __HIP_MEMORY_SCOPE_AGENT);
  vb += (int)xrank;
  for (int vt = vb; vt < total; vt += gridDim.x) {
    int e = 0;
    for (int i = 1; i < NEXP; ++i) e += (sm[i] <= vt) ? 1 : 0;
    const int row0 = (vt - sm[e]) * 64;
    const int cnt = counts[e];
    const int nrows = (cnt - row0 < 64) ? (cnt - row0) : 64;
    phase_f_tile(P, lds, e, row0, nrows);
  }
}

constexpr int PS = 264;
__device__ void phase_l_tile(const Params& P, LAS char* lds, const int tile) {
  int tid_ = threadIdx.x;
  asm volatile("" : "+v"(tid_));
  const int tid = tid_, lane = tid & 63, wave = __builtin_amdgcn_readfirstlane(tid >> 6);
  const int r = lane & 31, hh = lane >> 5;
  const int t0 = tile * 64;
  LAS _Float16* cc = (LAS _Float16*)(lds + LDS_TILE);
  LAS float* red = (LAS float*)(lds + LDS_RED);
  _Float16* scr = (_Float16*)(P.ws + OFF_Z) + (size_t)blockIdx.x * 16 * NTHREADS * 8;
  {
    LAS _Float16* pt = (LAS _Float16*)(lds + LDS_TILE);
#pragma unroll
    for (int it = 0; it < 8; ++it) {
      const int idx = tid + it * NTHREADS;
      const int row = idx >> 6, c4 = idx & 63;
      const float4 v = *(const float4*)(P.p + (size_t)(t0 + row) * DPLE + c4 * 4);
      half4 hv = {(_Float16)v.x, (_Float16)v.y, (_Float16)v.z, (_Float16)v.w};
      *(LAS half4*)(pt + row * PS + c4 * 4) = hv;
    }
  }
  __syncthreads();
  f32x16 acc[4][2];
  zero_acc<4>(acc);
  {
    const _Float16* wp = (const _Float16*)(P.ws + OFF_WPP) + (size_t)(wave * 4) * 16 * 512;
    const _Float16* const ab[4] = {wp, wp + 16 * 512, wp + 2 * 16 * 512, wp + 3 * 16 * 512};
    gemm_core<4, 4>(ab, lane * 8, 16, cc + r * PS + hh * 8, 32 * PS, acc);
  }
#pragma unroll
  for (int i = 0; i < 4; ++i)
#pragma unroll
    for (int nt = 0; nt < 2; ++nt)
#pragma unroll
      for (int hf = 0; hf < 2; ++hf) {
        half8 hv;
#pragma unroll
        for (int j = 0; j < 8; ++j) hv[j] = (_Float16)acc[i][nt][hf * 8 + j];
        *(half8*)(scr + ((size_t)((i * 2 + nt) * 2 + hf) * NTHREADS + tid) * 8) = hv;
      }
  __syncthreads();
  {
    const _Float16* hb = (const _Float16*)(P.ws + OFF_H);
    const _Float16* yb = (const _Float16*)(P.ws + OFF_YB);
    float g2[16], b2[16];
#pragma unroll
    for (int hf = 0; hf < 2; ++hf)
#pragma unroll
      for (int j4 = 0; j4 < 2; ++j4) {
        const float4 gv = *(const float4*)(P.ln2_g + hf * 512 + lane * 8 + j4 * 4), bv = *(const float4*)(P.ln2_b + hf * 512 + lane * 8 + j4 * 4);
        g2[hf * 8 + j4 * 4 + 0] = gv.x; g2[hf * 8 + j4 * 4 + 1] = gv.y; g2[hf * 8 + j4 * 4 + 2] = gv.z; g2[hf * 8 + j4 * 4 + 3] = gv.w;
        b2[hf * 8 + j4 * 4 + 0] = bv.x; b2[hf * 8 + j4 * 4 + 1] = bv.y; b2[hf * 8 + j4 * 4 + 2] = bv.z; b2[hf * 8 + j4 * 4 + 3] = bv.w;
      }
#pragma unroll 2
    for (int k = 0; k < 8; ++k) {
      const int row = wave * 8 + k;
      const size_t t = (size_t)(t0 + row);
      float v[16];
      float s = 0.f, ss = 0.f;
#pragma unroll
      for (int hf = 0; hf < 2; ++hf) {
        const half8 hv = *(const half8*)(hb + t * D + hf * 512 + lane * 8);
        const half8 y0 = *(const half8*)(yb + (2 * t) * D + hf * 512 + lane * 8);
        const half8 y1 = *(const half8*)(yb + (2 * t + 1) * D + hf * 512 + lane * 8);
#pragma unroll
        for (int j = 0; j < 8; ++j) {
          const float x = fmaf(ALPHA, (float)hv[j], (float)y0[j] + (float)y1[j]);
          v[hf * 8 + j] = x; s += x; ss = fmaf(x, x, ss);
        }
      }
#pragma unroll
      for (int o = 32; o > 0; o >>= 1) { s += __shfl_xor(s, o); ss += __shfl_xor(ss, o); }
      const float m = s * (1.f / D);
      const float rsd = rsqrtf(fmaxf(ss * (1.f / D) - m * m, 0.f) + EPS);
#pragma unroll
      for (int hf = 0; hf < 2; ++hf) {
        half8 o8;
#pragma unroll
        for (int j = 0; j < 8; ++j) o8[j] = (_Float16)((v[hf * 8 + j] - m) * rsd * g2[hf * 8 + j] + b2[hf * 8 + j]);
        *(LAS half8*)(cc + row * XS + hf * 512 + lane * 8) = o8;
      }
    }
  }
  __syncthreads();
  zero_acc<4>(acc);
  {
    const _Float16* wp = (const _Float16*)(P.ws + OFF_WPG) + (size_t)(wave * 4) * 64 * 512;
    const _Float16* const ab[4] = {wp, wp + 64 * 512, wp + 2 * 64 * 512, wp + 3 * 64 * 512};
    gemm_core<4, 2>(ab, lane * 8, 64, cc + r * XS + hh * 8, 32 * XS, acc);
  }
#pragma unroll
  for (int i = 0; i < 4; ++i)
#pragma unroll
    for (int nt = 0; nt < 2; ++nt)
#pragma unroll
      for (int hf = 0; hf < 2; ++hf) {
        const half8 pv = *(const half8*)(scr + ((size_t)((i * 2 + nt) * 2 + hf) * NTHREADS + tid) * 8);
#pragma unroll
        for (int q2 = 0; q2 < 2; ++q2) {
          const int q = hf * 2 + q2;
          const half4 yv = *(const LAS half4*)(cc + (nt * 32 + r) * XS + (wave * 4 + i) * 32 + q * 8 + hh * 4);
#pragma unroll
          for (int j = 0; j < 4; ++j) {
            const float gate = sigmoidf_(acc[i][nt][4 * q + j]);
            acc[i][nt][4 * q + j] = fmaf(ALPHA, (float)yv[j], (float)pv[q2 * 4 + j] * gate);
          }
        }
      }
  float mu[2], rs[2];
  ln_stats(acc, red, wave, lane, mu, rs);
#pragma unroll
  for (int i = 0; i < 4; ++i)
#pragma unroll
    for (int q = 0; q < 4; ++q) {
      const int ch0 = (wave * 4 + i) * 32 + q * 8 + hh * 4;
      const float4 gv = *(const float4*)(P.ln3_g + ch0), bv = *(const float4*)(P.ln3_b + ch0);
#pragma unroll
      for (int nt = 0; nt < 2; ++nt) {
        float4 o;
        o.x = (acc[i][nt][4 * q + 0] - mu[nt]) * rs[nt] * gv.x + bv.x;
        o.y = (acc[i][nt][4 * q + 1] - mu[nt]) * rs[nt] * gv.y + bv.y;
        o.z = (acc[i][nt][4 * q + 2] - mu[nt]) * rs[nt] * gv.z + bv.z;
        o.w = (acc[i][nt][4 * q + 3] - mu[nt]) * rs[nt] * gv.w + bv.w;
        *(float4*)(P.out + (size_t)(t0 + nt * 32 + r) * D + ch0) = o;
      }
    }
  __syncthreads();
}

#define XB_TMO      128
#define XB_XCNT(j)  (256  + 64 * (j))
#define XB_XSUB(j)  (1280 + 64 * (j))
#define XB_XGEN(j)  (2304 + 64 * (j))
#define XB_TOP      3328
#define XB_TOPGEN   3392
#define XCD_BAR_WORDS 3456
#define XB_SPIN_CAP (1u << 18)
__device__ __forceinline__ unsigned xb_ld(unsigned* p)              { return __hip_atomic_load(p, __ATOMIC_RELAXED, __HIP_MEMORY_SCOPE_AGENT); }
__device__ __forceinline__ unsigned xb_add(unsigned* p, unsigned v) { return __hip_atomic_fetch_add(p, v, __ATOMIC_RELAXED, __HIP_MEMORY_SCOPE_AGENT); }
__device__ __forceinline__ unsigned xb_xcc_id() { return (unsigned)__builtin_amdgcn_s_getreg((3 << 11) | 20) & 0xFu; }
#define XB_SPIN(cond, bar) do { unsigned _sp = 0; while (cond) { __builtin_amdgcn_s_sleep(1); \
    if ((++_sp & 255u) == 0u) { if (xb_ld(&(bar)[XB_TMO])) break; if (_sp > XB_SPIN_CAP) { atomicAdd(&(bar)[XB_TMO], 1u); break; } } } } while (0)
struct XcdBarrier { unsigned* bar; unsigned x; volatile LAS unsigned* st; };
__device__ __forceinline__ XcdBarrier xcd_barrier_post(unsigned* bar, volatile LAS unsigned* st) {
  XcdBarrier b; b.bar = bar; b.x = xb_xcc_id(); b.st = st;
  if (threadIdx.x == 0) (void)xb_add(&bar[XB_XCNT(b.x)], 1u);
  return b;
}
__device__ __forceinline__ void xcd_barrier_complete(unsigned* bar, unsigned x, unsigned& nloc, unsigned& nx) {
  const unsigned G = gridDim.x * gridDim.y * gridDim.z;
  unsigned sum, cnt, mine, sp = 0u;
  for (;;) {
    sum = 0u; cnt = 0u; mine = 0u;
#pragma unroll
    for (unsigned j = 0; j < 16; ++j) { const unsigned c = xb_ld(&bar[XB_XCNT(j)]); sum += c; cnt += (c > 0u) ? 1u : 0u; mine = (j == x) ? c : mine; }
    if (sum == G) break;
    __builtin_amdgcn_s_sleep(1);
    if ((++sp & 255u) == 0u) { if (xb_ld(&bar[XB_TMO])) break; if (sp > XB_SPIN_CAP) { atomicAdd(&bar[XB_TMO], 1u); break; } }
  }
  nloc = mine > 0u ? mine : 1u; nx = cnt > 0u ? cnt : 1u;
}
__device__ __forceinline__ void xcd_barrier(const XcdBarrier& b) {
  asm volatile("s_waitcnt vmcnt(0)" ::: "memory");
  __syncthreads();
  if (threadIdx.x == 0) {
    unsigned* bar = b.bar;
    __builtin_amdgcn_s_waitcnt(0);
    unsigned nloc = b.st[0], nx = b.st[1];
    if (nloc == 0u) { xcd_barrier_complete(bar, b.x, nloc, nx); b.st[0] = nloc; b.st[1] = nx; }
    const unsigned old = xb_add(&bar[XB_XSUB(b.x)], 1u);
    const unsigned gen = old / nloc;
    if (old + 1u == (gen + 1u) * nloc) {
      __builtin_amdgcn_fence(__ATOMIC_RELEASE, "agent");
      asm volatile("s_waitcnt vmcnt(0)" ::: "memory");
      const unsigned og = xb_add(&bar[XB_TOP], 1u);
      const unsigned tg = og / nx;
      if (og + 1u == (tg + 1u) * nx) xb_add(&bar[XB_TOPGEN], 1u);
      else XB_SPIN(xb_ld(&bar[XB_TOPGEN]) == tg, bar);
      __builtin_amdgcn_fence(__ATOMIC_ACQUIRE, "agent");
      xb_add(&bar[XB_XGEN(b.x)], 1u);
      asm volatile("s_waitcnt vmcnt(0)" ::: "memory");
    } else {
      XB_SPIN(xb_ld(&bar[XB_XGEN(b.x)]) == gen, bar);
      __builtin_amdgcn_fence(__ATOMIC_ACQUIRE, "agent");
      asm volatile("s_waitcnt vmcnt(0)" ::: "memory");
    }
  }
  __syncthreads();
}

__global__ void __launch_bounds__(NTHREADS) k_mega(Params P) {
  extern __shared__ __attribute__((aligned(16))) char lds_raw[];
  LAS char* lds = (LAS char*)lds_raw;
  if (threadIdx.x < 4) ((LAS unsigned*)(lds + LDS_BAR))[threadIdx.x] = 0u;
  __syncthreads();
  const XcdBarrier bar = xcd_barrier_post((unsigned*)(P.ws + OFF_BAR), (volatile LAS unsigned*)(lds + LDS_BAR));
  if (threadIdx.x == 0) ((LAS unsigned*)(lds + LDS_BAR))[2] = xb_add((unsigned*)(P.ws + OFF_CNT + 2048) + 16 * bar.x, 1u);
  phase_pack(P);
  xcd_barrier(bar);
  for (int tile = blockIdx.x; tile < NTILES; tile += gridDim.x) phase_z_tile(P, lds, tile);
  xcd_barrier(bar);
  {
    const int ustride = gridDim.x * NTHREADS;
    int pack_base = 0;
    const int ntb = (NTILES - 1 - (int)blockIdx.x) / (int)gridDim.x;
    for (int tile = blockIdx.x + ntb * gridDim.x; tile >= (int)blockIdx.x; tile -= gridDim.x) { phase_m_tile(P, lds, tile, pack_base); pack_base += 24 * ustride; }
    for (int u = pack_base + blockIdx.x * NTHREADS + threadIdx.x; u < PACK_UNITS; u += 3 * ustride) {
      float pv[3][8];
      pack_issue(P, u, ustride, pv);
      pack_commit(P, u, ustride, pv);
    }
  }
  xcd_barrier(bar);
  phase_f(P, lds, bar.x, ((LAS unsigned*)(lds + LDS_BAR))[2]);
  xcd_barrier(bar);
  for (int tile = blockIdx.x; tile < NTILES; tile += gridDim.x) phase_l_tile(P, lds, tile);
}
}

static Params make_params(void* const* d_in, void* d_out, void* d_ws) {
  Params P{};
  const float** f = (const float**)&P;
  for (int i = 0; i < 25; ++i) f[i] = (const float*)d_in[i];
  P.out = (float*)d_out;
  P.ws = (char*)d_ws;
  return P;
}

extern "C" void kernel_launch(void* const* d_in, const int* in_sizes, int n_in, void* d_out, int out_size, void* d_ws, size_t ws_size, hipStream_t stream) {
  static int grid = 0;
  if (grid == 0) {
    if (ws_size < OFF_END || n_in != 25) { fprintf(stderr, "kernel_launch: bad ws/n_in: %zu < %zu, n_in %d\n", ws_size, (size_t)OFF_END, n_in); grid = -1; return; }
    int dev = 0, cus = 0, per_cu = 0;
    (void)hipGetDevice(&dev);
    (void)hipDeviceGetAttribute(&cus, hipDeviceAttributeMultiprocessorCount, dev);
    (void)hipFuncSetAttribute((const void*)k_mega, hipFuncAttributeMaxDynamicSharedMemorySize, LDS_BYTES);
    (void)hipOccupancyMaxActiveBlocksPerMultiprocessor(&per_cu, (const void*)k_mega, NTHREADS, LDS_BYTES);
    if (per_cu < 1) { fprintf(stderr, "kernel_launch: occupancy query says %d blocks/CU\n", per_cu); }
    (void)hipGetLastError();
    grid = cus;
  }
  if (grid < 0) return;
  (void)hipMemsetAsync(d_ws, 0, CTRL_BYTES, stream);
  Params P = make_params(d_in, d_out, d_ws);
  void* args[] = {&P};
  hipError_t e = hipLaunchCooperativeKernel((const void*)k_mega, dim3(grid), dim3(NTHREADS), args, LDS_BYTES, stream);
  if (e != hipSuccess) fprintf(stderr, "kernel_launch: cooperative launch failed: %s (grid %d)\n", hipGetErrorString(e), grid);
}
```

```cpp
#include <hip/hip_runtime.h>
#include <hip/hip_fp16.h>
#include <cstdio>
#include <cstdint>

namespace {
constexpr int T = 32768, SEQ = 8192, D = 1024, DIN = 1536, DPOOL = 512, DCONV = 512, DEXP = 512, DPLE = 256;
constexpr int NEXP = 32, CW = 31;
constexpr float ALPHA = 1.189207115002721f;
constexpr float EPS = 1e-5f;
constexpr int NTHREADS = 512;
constexpr int NTILES = T / 64;
constexpr int XS = 1032;

constexpr int LDS_TILE = 0;
constexpr int LDS_AUX = 64 * XS * 2;
constexpr int LDS_RED = LDS_AUX + 25600;
constexpr int LDS_BAR = LDS_RED + 4096;
constexpr int LDS_BYTES = LDS_BAR + 16 + (512);
typedef _Float16 half8 __attribute__((ext_vector_type(8)));
typedef _Float16 half4 __attribute__((ext_vector_type(4)));
typedef _Float16 half2v __attribute__((ext_vector_type(2)));
typedef float f32x16 __attribute__((ext_vector_type(16)));
#define LAS __attribute__((address_space(3)))
#define MFMA(a, b, c) __builtin_amdgcn_mfma_f32_32x32x16_f16((a), (b), (c), 0, 0, 0)

constexpr size_t OFF_BAR  = 0;
constexpr size_t OFF_CNT  = 16384;
constexpr size_t CTRL_BYTES = 20480;
constexpr size_t OFF_LIST = CTRL_BYTES;
constexpr size_t OFF_WGT  = OFF_LIST + (size_t)NEXP * T * 4;
constexpr size_t OFF_WIN  = OFF_WGT + (size_t)2 * T * 4;
constexpr size_t OFF_WOUT = OFF_WIN + (size_t)DIN * D * 2;
constexpr size_t OFF_WR   = OFF_WOUT + (size_t)D * D * 2;
constexpr size_t OFF_WG   = OFF_WR + (size_t)64 * D * 2;
constexpr size_t OFF_WU   = OFF_WG + (size_t)NEXP * D * DEXP * 2;
constexpr size_t OFF_WD   = OFF_WU + (size_t)NEXP * D * DEXP * 2;
constexpr size_t OFF_WPP  = OFF_WD + (size_t)NEXP * D * DEXP * 2;
constexpr size_t OFF_WPG  = OFF_WPP + (size_t)DPLE * D * 2;
constexpr size_t OFF_Z    = OFF_WPG + (size_t)D * D * 2;
constexpr size_t OFF_CC   = OFF_Z + (size_t)T * DIN * 2;
constexpr size_t OFF_H    = OFF_CC + (size_t)T * D * 2;
constexpr size_t OFF_YB   = OFF_H + (size_t)T * D * 2;
constexpr size_t OFF_END  = OFF_YB + (size_t)2 * T * D * 2;

struct Params {
  const float *x, *p, *w_in, *w_pool_mix, *pool_scale, *w_dw, *b_dw, *conv_ln_g, *conv_ln_b, *w_out, *ln1_g, *ln1_b, *w_coarse, *b_coarse, *w_fine,
      *b_fine, *w_gate, *w_up, *w_down, *ln2_g, *ln2_b, *w_ple_proj, *w_ple_gate, *ln3_g, *ln3_b;
  float* out;
  char* ws;
};

__device__ __forceinline__ float sigmoidf_(float x) { return __builtin_amdgcn_rcpf(1.f + __expf(-x)); }
__device__ __forceinline__ float siluf_(float x) { return x * __builtin_amdgcn_rcpf(1.f + __expf(-x)); }


#ifndef PROBE_ON
#define PROBE_ON 0
#define PROBE_MASK 0ull
#endif
#define PROBE_MULT 1
#define LDS_PROF (LDS_BYTES - 512)
__device__ __forceinline__ void tick(LAS char* lds, const int k) {
  if (PROBE_ON && blockIdx.x == 0 && threadIdx.x == 448) {
    LAS unsigned long long* pf = (LAS unsigned long long*)(lds + LDS_PROF);
    const unsigned long long now = __builtin_amdgcn_s_memrealtime();
    pf[1 + k] += now - pf[0];
    pf[0] = now;
  }
}
template <class F>
__device__ __forceinline__ void pack_mat(_Float16* __restrict__ dst, const int NB, const int K, const int N, F src, const int gtid, const int gth) {
  const int KT = K / 16, MT = N / 32;
  const int total = NB * MT * KT * 64;
  for (int idx = gtid; idx < total; idx += gth) {
    const int lane = idx & 63;
    int f = idx >> 6;
    const int kt = f % KT; f /= KT;
    const int mt = f % MT; const int b = f / MT;
    const int k0 = kt * 16 + (lane >> 5) * 8, n = mt * 32 + (lane & 31);
    half8 v;
#pragma unroll
    for (int j = 0; j < 8; ++j) v[j] = (_Float16)src(b, k0 + j, n);
    *(half8*)(dst + (size_t)idx * 8) = v;
  }
}

__device__ void phase_pack(const Params& P) {
  const int gtid = blockIdx.x * NTHREADS + threadIdx.x, gth = gridDim.x * NTHREADS;
  char* ws = P.ws;
  {
    _Float16* dst = (_Float16*)(ws + OFF_WIN);
    const int total = 48 * 64 * 64;
    for (int idx = gtid; idx < total; idx += gth) {
      const int lane = idx & 63;
      const int f = idx >> 6;
      const int kt = f & 63, mt = f >> 6;
      const int k0 = kt * 16 + (lane >> 5) * 8, n = mt * 32 + (lane & 31);
      half8 v;
      if (mt >= 16) {
#pragma unroll
        for (int j = 0; j < 8; ++j) v[j] = (_Float16)P.w_in[(size_t)(k0 + j) * DIN + n];
      } else {
        const int g = n >> 7, d = n & 127;
        float acc[8];
#pragma unroll
        for (int j = 0; j < 8; ++j) acc[j] = 0.f;
        const float* wpm = P.w_pool_mix + (size_t)g * 128 * 128 + d;
        const float* wi = P.w_in + (size_t)k0 * DIN + g * 128;
#pragma unroll 8
        for (int c = 0; c < 128; ++c) {
          const float m = wpm[c * 128];
#pragma unroll
          for (int j = 0; j < 8; ++j) acc[j] = fmaf(wi[(size_t)j * DIN + c], m, acc[j]);
        }
        const float sc = P.pool_scale[n];
#pragma unroll
        for (int j = 0; j < 8; ++j) v[j] = (_Float16)(acc[j] * sc);
      }
      *(half8*)(dst + (size_t)idx * 8) = v;
    }
  }
  pack_mat((_Float16*)(ws + OFF_WOUT), 1, D, D, [&](int, int k, int n) { return P.w_out[(size_t)k * D + n]; }, gtid, gth);
  pack_mat((_Float16*)(ws + OFF_WR), 1, D, 64, [&](int, int k, int n) { return n < 4 ? P.w_coarse[k * 4 + n] : (n < 36 ? P.w_fine[k * 32 + n - 4] : 0.f); }, gtid, gth);
  pack_mat((_Float16*)(ws + OFF_WPP), 1, DPLE, D, [&](int, int k, int n) { return P.w_ple_proj[(size_t)k * D + n]; }, gtid, gth);
  pack_mat((_Float16*)(ws + OFF_WPG), 1, D, D, [&](int, int k, int n) { return P.w_ple_gate[(size_t)k * D + n]; }, gtid, gth);
}

template <int NA, int PF>
__device__ __forceinline__ void gemm_core(const _Float16* const (&ab)[NA], const int lane_off, const int KT,
                                          const LAS _Float16* bp, const int nt_stride, f32x16 (&acc)[NA][2]) {
  half8 abuf[PF][NA];
#pragma unroll
  for (int s = 0; s < PF; ++s)
#pragma unroll
    for (int i = 0; i < NA; ++i) abuf[s][i] = *(const half8*)(ab[i] + s * 512 + lane_off);
  half8 bb[2][2];
  bb[0][0] = *(const LAS half8*)(bp);
  bb[0][1] = *(const LAS half8*)(bp + nt_stride);
#pragma unroll 1
  for (int kt = 0; kt < KT; kt += PF) {
#pragma unroll
    for (int s = 0; s < PF; ++s) {
      const int k = kt + s;
      const int kb = (k + 1 < KT) ? (k + 1) : (KT - 1);
      bb[(s + 1) & 1][0] = *(const LAS half8*)(bp + kb * 16);
      bb[(s + 1) & 1][1] = *(const LAS half8*)(bp + nt_stride + kb * 16);
      __builtin_amdgcn_sched_barrier(0);
#pragma unroll
      for (int i = 0; i < NA; ++i) {
        acc[i][0] = MFMA(abuf[s][i], bb[s & 1][0], acc[i][0]);
        acc[i][1] = MFMA(abuf[s][i], bb[s & 1][1], acc[i][1]);
      }
      const int kn = (k + PF < KT) ? (k + PF) : (KT - 1);
#pragma unroll
      for (int i = 0; i < NA; ++i) abuf[s][i] = *(const half8*)(ab[i] + kn * 512 + lane_off);
      __builtin_amdgcn_sched_barrier(0);
    }
  }
}

template <int NA>
__device__ __forceinline__ void zero_acc(f32x16 (&acc)[NA][2]) {
#pragma unroll
  for (int i = 0; i < NA; ++i)
#pragma unroll
    for (int n = 0; n < 2; ++n)
#pragma unroll
      for (int r = 0; r < 16; ++r) acc[i][n][r] = 0.f;
}

constexpr int PACK_UNITS = 3 << 21;
__device__ __forceinline__ void pack_issue(const Params& P, const int u0, const int ustride, float (&pv)[3][8]) {
#pragma unroll
  for (int q = 0; q < 3; ++q) {
    const int u = u0 + q * ustride;
    if (u < PACK_UNITS) {
      const int m = u >> 21, idx = u & ((1 << 21) - 1), lane = idx & 63, f = idx >> 6, e = f >> 10;
      const int r = lane & 31, hh = lane >> 5;
      const float* src;
      int stride;
      if (m < 2) {
        const int kt = f & 63, mt = (f >> 6) & 15;
        src = (m == 0 ? P.w_gate : P.w_up) + ((size_t)e * D + kt * 16 + hh * 8) * DEXP + mt * 32 + r;
        stride = DEXP;
      } else {
        const int kt = f & 31, mt = (f >> 5) & 31;
        src = P.w_down + ((size_t)e * DEXP + kt * 16 + hh * 8) * D + mt * 32 + r;
        stride = D;
      }
#pragma unroll
      for (int j = 0; j < 8; ++j) pv[q][j] = src[(size_t)j * stride];
    }
  }
}
__device__ __forceinline__ void pack_commit(const Params& P, const int u0, const int ustride, const float (&pv)[3][8]) {
#pragma unroll
  for (int q = 0; q < 3; ++q) {
    const int u = u0 + q * ustride;
    if (u < PACK_UNITS) {
      half8 v;
#pragma unroll
      for (int j = 0; j < 8; ++j) v[j] = (_Float16)pv[q][j];
      *(half8*)((_Float16*)(P.ws + OFF_WG) + (size_t)u * 8) = v;
    }
  }
}

__device__ __forceinline__ void z_x_issue(const Params& P, const int tile, float4 (&xv)[32]) {
  const int tid = threadIdx.x;
#pragma unroll
  for (int it = 0; it < 32; ++it) {
    const int idx = tid + it * NTHREADS;
    xv[it] = *(const float4*)(P.x + (size_t)(tile * 64 + (idx >> 8)) * D + (idx & 255) * 4);
  }
}
__device__ __forceinline__ void z_x_commit(LAS char* lds, const float4 (&xv)[32]) {
  const int tid = threadIdx.x;
  LAS _Float16* xt = (LAS _Float16*)lds;
#pragma unroll
  for (int it = 0; it < 32; ++it) {
    const int idx = tid + it * NTHREADS;
    const half4 hv = {(_Float16)xv[it].x, (_Float16)xv[it].y, (_Float16)xv[it].z, (_Float16)xv[it].w};
    *(LAS half4*)(xt + (idx >> 8) * XS + (idx & 255) * 4) = hv;
  }
}
__device__ void phase_z_tile(const Params& P, LAS char* lds, const int tile, const bool preloaded) {
  const int tid = threadIdx.x, lane = tid & 63, wave = __builtin_amdgcn_readfirstlane(tid >> 6);
  const int r = lane & 31, hh = lane >> 5;
  LAS _Float16* xt = (LAS _Float16*)lds;
  const int t0 = tile * 64;
  if (!preloaded) {
#pragma unroll 8
    for (int it = 0; it < 32; ++it) {
      const int idx = tid + it * NTHREADS;
      const int row = idx >> 8, c4 = idx & 255;
      const float4 v = *(const float4*)(P.x + (size_t)(t0 + row) * D + c4 * 4);
      half4 hv = {(_Float16)v.x, (_Float16)v.y, (_Float16)v.z, (_Float16)v.w};
      *(LAS half4*)(xt + row * XS + c4 * 4) = hv;
    }
  }
  __syncthreads();
  tick(lds, 10);
  {
    _Float16* xc = (_Float16*)(P.ws + OFF_CC) + (size_t)(tile * 8 + wave) * 16 * 512;
#pragma unroll
    for (int i = 0; i < 4; ++i)
#pragma unroll
      for (int nt = 0; nt < 2; ++nt)
#pragma unroll
        for (int qp = 0; qp < 2; ++qp) {
          const LAS _Float16* src = xt + (nt * 32 + r) * XS + (wave * 4 + i) * 32 + qp * 16 + hh * 4;
          const half4 lo = *(const LAS half4*)(src), hi = *(const LAS half4*)(src + 8);
          const half8 v = {lo[0], lo[1], lo[2], lo[3], hi[0], hi[1], hi[2], hi[3]};
          *(half8*)(xc + ((i * 2 + nt) * 2 + qp) * 512 + lane * 8) = v;
        }
  }
  tick(lds, 9);
  const _Float16* wp = (const _Float16*)(P.ws + OFF_WIN);
  _Float16* zN = (_Float16*)(P.ws + OFF_Z);
  const LAS _Float16* bp = xt + r * XS + hh * 8;
#pragma unroll 1
  for (int pass = 0; pass < 2; ++pass) {
    f32x16 acc[3][2];
    zero_acc<3>(acc);
    const int mt0 = pass * 24 + wave * 3;
    const _Float16* const ab[3] = {wp + (size_t)mt0 * 64 * 512, wp + (size_t)(mt0 + 1) * 64 * 512, wp + (size_t)(mt0 + 2) * 64 * 512};
    gemm_core<3, 4>(ab, lane * 8, 64, bp, 32 * XS, acc);
    tick(lds, 11);
#pragma unroll
    for (int i = 0; i < 3; ++i)
#pragma unroll
      for (int nt = 0; nt < 2; ++nt)
#pragma unroll
        for (int q = 0; q < 4; ++q) {
          half4 hv = {(_Float16)acc[i][nt][4 * q], (_Float16)acc[i][nt][4 * q + 1], (_Float16)acc[i][nt][4 * q + 2], (_Float16)acc[i][nt][4 * q + 3]};
          const size_t off = ((((size_t)tile * 48 + (mt0 + i)) * 2 + nt) * 4 + q) * 256 + lane * 4;
          *(half4*)(zN + off) = hv;
        }
  }
  __syncthreads();
}


__device__ __forceinline__ void ln_stats(const f32x16 (&v)[4][2], LAS float* red, const int wave, const int lane, float (&mu)[2], float (&rs)[2]) {
  const int r = lane & 31, hh = lane >> 5;
#pragma unroll
  for (int nt = 0; nt < 2; ++nt) {
    float s = 0.f, ss = 0.f;
#pragma unroll
    for (int i = 0; i < 4; ++i)
#pragma unroll
      for (int g = 0; g < 16; ++g) { const float x = v[i][nt][g]; s += x; ss = fmaf(x, x, ss); }
    s += __shfl_xor(s, 32);
    ss += __shfl_xor(ss, 32);
    if (hh == 0) { red[(wave * 64 + nt * 32 + r) * 2] = s; red[(wave * 64 + nt * 32 + r) * 2 + 1] = ss; }
  }
  __syncthreads();
#pragma unroll
  for (int nt = 0; nt < 2; ++nt) {
    float s = 0.f, ss = 0.f;
#pragma unroll
    for (int w = 0; w < 8; ++w) { s += red[(w * 64 + nt * 32 + r) * 2]; ss += red[(w * 64 + nt * 32 + r) * 2 + 1]; }
    const float m = s * (1.f / D);
    const float var = fmaxf(ss * (1.f / D) - m * m, 0.f);
    mu[nt] = m;
    rs[nt] = rsqrtf(var + EPS);
  }
}


constexpr int RS = 100;
constexpr int WST_BYTES = 16 * RS * 2;
__device__ __forceinline__ void fill_issue_w(const _Float16* __restrict__ zN, const int tile, const int g, const bool has_prev, const int wave, const int lane,
                                             half4 (&za)[6], half4 (&zb)[6]) {
  const bool glu = g >= 4;
  const int mtl = (glu ? 16 + (g - 4) * 4 : g * 4) + (wave >> 1), q0 = (wave & 1) * 2;
#pragma unroll
  for (int uu = 0; uu < 6; ++uu) {
    const int st = uu >> 1, q = q0 + (uu & 1);
    const int ztile = (st == 0) ? tile - 1 : tile;
    const int nt = (st == 0) ? 1 : st - 1;
    const half4 z0 = {(_Float16)0.f, (_Float16)0.f, (_Float16)0.f, (_Float16)0.f};
    za[uu] = z0; zb[uu] = z0;
    if (st != 0 || has_prev) {
      const size_t off = ((((size_t)ztile * 48 + mtl) * 2 + nt) * 4 + q) * 256 + lane * 4;
      za[uu] = *(const half4*)(zN + off);
      if (glu) zb[uu] = *(const half4*)(zN + off + (size_t)16 * 2 * 4 * 256);
    }
  }
}
__device__ __forceinline__ void fill_commit_w(LAS _Float16* wst, const bool glu, const int lane, const half4 (&za)[6], const half4 (&zb)[6]) {
  const int r = lane & 31, hh = lane >> 5;
#pragma unroll
  for (int uu = 0; uu < 6; ++uu) {
    const int st = uu >> 1, qq = uu & 1;
#pragma unroll
    for (int e = 0; e < 4; ++e) {
      float v = (float)za[uu][e];
      if (glu) v *= sigmoidf_((float)zb[uu][e]);
      wst[(qq * 8 + hh * 4 + e) * RS + st * 32 + r] = (_Float16)v;
    }
  }
}
__device__ __forceinline__ float seg16_treduce(const float (&v)[16]) {
  const int lane = threadIdx.x & 63;
  float a8[8], a4[4], a2[2];
  {
    const bool up = (lane & 8) != 0;
#pragma unroll
    for (int i = 0; i < 8; ++i) { const float keep = up ? v[i + 8] : v[i], send = up ? v[i] : v[i + 8]; a8[i] = keep + __shfl_xor(send, 8); }
  }
  {
    const bool up = (lane & 4) != 0;
#pragma unroll
    for (int i = 0; i < 4; ++i) { const float keep = up ? a8[i + 4] : a8[i], send = up ? a8[i] : a8[i + 4]; a4[i] = keep + __shfl_xor(send, 4); }
  }
  {
    const bool up = (lane & 2) != 0;
#pragma unroll
    for (int i = 0; i < 2; ++i) { const float keep = up ? a4[i + 2] : a4[i], send = up ? a4[i] : a4[i + 2]; a2[i] = keep + __shfl_xor(send, 2); }
  }
  const bool up = (lane & 1) != 0;
  const float keep = up ? a2[1] : a2[0], send = up ? a2[0] : a2[1];
  return keep + __shfl_xor(send, 1);
}
template <int W>
__device__ __forceinline__ void pool_group_w(const LAS _Float16* wst, LAS _Float16* cc, const int g, const int s0, const int wave, const int lane) {
  const int c = lane & 15, tg = lane >> 4;
  float v[32];
#pragma unroll
  for (int i = 0; i < 16; ++i) {
    const half2v p = *(const LAS half2v*)(wst + c * RS + 16 + tg * 16 + 2 * i);
    v[2 * i] = (float)p[0]; v[2 * i + 1] = (float)p[1];
  }
  float S = 0.f;
#pragma unroll
  for (int i = 0; i < W; ++i) S += v[16 - i];
#pragma unroll
  for (int j = 0; j < 16; ++j) {
    if (j > 0) S += v[16 + j] - v[16 + j - W];
    const int s = s0 + tg * 16 + j;
    const int cnt = (s + 1 < W) ? (s + 1) : W;
    const float o = S * __builtin_amdgcn_rcpf((float)cnt) - v[16 + j];
    cc[(tg * 16 + j) * XS + g * 128 + wave * 16 + c] = (_Float16)o;
  }
}

__device__ void phase_m_tile(const Params& P, LAS char* lds, const int tile, int& pack_j) {
  int tid_ = threadIdx.x;
  asm volatile("" : "+v"(tid_));
  const int tid = tid_, lane = tid & 63, wave = __builtin_amdgcn_readfirstlane(tid >> 6);
  const int r = lane & 31, hh = lane >> 5;
  const int t0 = tile * 64;
  const int s0 = t0 % SEQ;
  const bool has_prev = (s0 != 0);
  const _Float16* zN = (const _Float16*)(P.ws + OFF_Z);
  LAS _Float16* cc = (LAS _Float16*)(lds + LDS_TILE);
  LAS _Float16* ub = (LAS _Float16*)(lds + LDS_AUX);
  LAS float* red = (LAS float*)(lds + LDS_RED);

  const int ustride = gridDim.x * NTHREADS;
  LAS _Float16* wst = (LAS _Float16*)(lds + LDS_AUX + wave * WST_BYTES);
  const int c16 = lane & 15, tg = lane >> 4;
  half4 za[6], zb[6];
  fill_issue_w(zN, tile, 0, has_prev, wave, lane, za, zb);
#pragma unroll 1
  for (int g = 0; g < 8; ++g) {
    const bool glu = g >= 4;
    const int hd = g - 4, ch = (glu ? hd : 0) * 128 + wave * 16 + c16;
    fill_commit_w(wst, glu, lane, za, zb);
    if (g < 7) fill_issue_w(zN, tile, g + 1, has_prev, wave, lane, za, zb);
    float wv[CW];
    float bias = 0.f, g_ = 0.f, b_ = 0.f;
    if (glu) {
#pragma unroll
      for (int jj = 0; jj < CW; ++jj) wv[jj] = P.w_dw[jj * DCONV + ch];
      bias = P.b_dw[ch]; g_ = P.conv_ln_g[ch]; b_ = P.conv_ln_b[ch];
    } else {
#pragma unroll
      for (int jj = 0; jj < CW; ++jj) wv[jj] = 0.f;
    }
    float pv[3][8];
    const bool do_pack = true;
    const int pu = pack_j * ustride + blockIdx.x * NTHREADS + tid;
    if (do_pack) pack_issue(P, pu, ustride, pv);
    if (!glu) {
      if (g == 0) pool_group_w<2>(wst, cc, 0, s0, wave, lane);
      else if (g == 1) pool_group_w<4>(wst, cc, 1, s0, wave, lane);
      else if (g == 2) pool_group_w<8>(wst, cc, 2, s0, wave, lane);
      else pool_group_w<16>(wst, cc, 3, s0, wave, lane);
    } else {
      float y[16];
      {
        float uv[46];
#pragma unroll
        for (int i = 0; i < 23; ++i) {
          const half2v p = *(const LAS half2v*)(wst + c16 * RS + tg * 16 + 2 + 2 * i);
          uv[2 * i] = (float)p[0]; uv[2 * i + 1] = (float)p[1];
        }
#pragma unroll
        for (int j = 0; j < 16; ++j) y[j] = bias;
#pragma unroll
        for (int jj = 0; jj < CW; ++jj) {
#pragma unroll
          for (int j = 0; j < 16; ++j) y[j] = fmaf(wv[jj], uv[j + jj], y[j]);
        }
      }
      float t1, t2;
      {
        float sq[16];
#pragma unroll
        for (int j = 0; j < 16; ++j) sq[j] = y[j] * y[j];
        t1 = seg16_treduce(y);
        t2 = seg16_treduce(sq);
      }
      __syncthreads();
      red[(wave * 64 + lane) * 2] = t1;
      red[(wave * 64 + lane) * 2 + 1] = t2;
      __syncthreads();
      float s1 = 0.f, s2 = 0.f;
#pragma unroll
      for (int w = 0; w < 8; ++w) { s1 += red[(w * 64 + lane) * 2]; s2 += red[(w * 64 + lane) * 2 + 1]; }
      const float m_l = s1 * (1.f / 128.f);
      const float r_l = rsqrtf(fmaxf(s2 * (1.f / 128.f) - m_l * m_l, 0.f) + EPS);
#pragma unroll
      for (int j = 0; j < 16; ++j) {
        const float m = __shfl(m_l, tg * 16 + j), rsd = __shfl(r_l, tg * 16 + j);
        const float v = (y[j] - m) * rsd * g_ + b_;
        cc[(tg * 16 + j) * XS + 512 + ch] = (_Float16)siluf_(v);
      }
    }
    if (do_pack) { pack_commit(P, pu, ustride, pv); pack_j += 3; }
  }
  __syncthreads();
  tick(lds, 13);

  f32x16 acc[4][2];
  zero_acc<4>(acc);
  {
    const _Float16* wp = (const _Float16*)(P.ws + OFF_WOUT) + (size_t)(wave * 4) * 64 * 512;
    const _Float16* const ab[4] = {wp, wp + 64 * 512, wp + 2 * 64 * 512, wp + 3 * 64 * 512};
    gemm_core<4, 4>(ab, lane * 8, 64, cc + r * XS + hh * 8, 32 * XS, acc);
  }
  tick(lds, 14);
  {
    const _Float16* xc = (const _Float16*)(P.ws + OFF_CC) + (size_t)(tile * 8 + wave) * 16 * 512;
#pragma unroll
    for (int i = 0; i < 4; ++i)
#pragma unroll
      for (int nt = 0; nt < 2; ++nt)
#pragma unroll
        for (int qp = 0; qp < 2; ++qp) {
          const half8 xv = *(const half8*)(xc + ((i * 2 + nt) * 2 + qp) * 512 + lane * 8);
#pragma unroll
          for (int j = 0; j < 4; ++j) {
            acc[i][nt][8 * qp + j] = fmaf(ALPHA, (float)xv[j], acc[i][nt][8 * qp + j]);
            acc[i][nt][8 * qp + 4 + j] = fmaf(ALPHA, (float)xv[4 + j], acc[i][nt][8 * qp + 4 + j]);
          }
        }
  }
  float mu[2], rs[2];
  ln_stats(acc, red, wave, lane, mu, rs);
#pragma unroll
  for (int i = 0; i < 4; ++i)
#pragma unroll
    for (int q = 0; q < 4; ++q) {
      const int ch0 = (wave * 4 + i) * 32 + q * 8 + hh * 4;
      const float4 gv = *(const float4*)(P.ln1_g + ch0), bv = *(const float4*)(P.ln1_b + ch0);
#pragma unroll
      for (int nt = 0; nt < 2; ++nt) {
        half4 hv;
        hv[0] = (_Float16)((acc[i][nt][4 * q + 0] - mu[nt]) * rs[nt] * gv.x + bv.x);
        hv[1] = (_Float16)((acc[i][nt][4 * q + 1] - mu[nt]) * rs[nt] * gv.y + bv.y);
        hv[2] = (_Float16)((acc[i][nt][4 * q + 2] - mu[nt]) * rs[nt] * gv.z + bv.z);
        hv[3] = (_Float16)((acc[i][nt][4 * q + 3] - mu[nt]) * rs[nt] * gv.w + bv.w);
        *(LAS half4*)(cc + (nt * 32 + r) * XS + ch0) = hv;
      }
    }
  __syncthreads();
  tick(lds, 15);
  LAS int* hist = (LAS int*)(lds + LDS_RED);
  if (tid < 64) hist[tid] = 0;
  LAS float* lg = (LAS float*)(lds + LDS_AUX);
  {
    const int ct = wave & 1, nt = (wave >> 1) & 1, kh = wave >> 2;
    const _Float16* ap = (const _Float16*)(P.ws + OFF_WR) + ((size_t)ct * 64 + kh * 32) * 512 + lane * 8;
    half8 rf[32];
#pragma unroll
    for (int kt = 0; kt < 32; ++kt) rf[kt] = *(const half8*)(ap + kt * 512);
    {
      _Float16* hb = (_Float16*)(P.ws + OFF_H);
#pragma unroll 8
      for (int it = 0; it < 16; ++it) {
        const int idx = tid + it * NTHREADS;
        const int row = idx >> 7, ck = idx & 127;
        const half8 v = *(const LAS half8*)(cc + row * XS + ck * 8);
        *(half8*)(hb + (size_t)(t0 + row) * D + ck * 8) = v;
      }
    }
    f32x16 ra;
#pragma unroll
    for (int g = 0; g < 16; ++g) ra[g] = 0.f;
    const LAS _Float16* bp = cc + (nt * 32 + r) * XS + kh * 512 + hh * 8;
#pragma unroll
    for (int kt = 0; kt < 32; ++kt) {
      const half8 b = *(const LAS half8*)(bp + kt * 16);
      ra = MFMA(rf[kt], b, ra);
    }
    if (kh == 1) {
#pragma unroll
      for (int g = 0; g < 16; ++g) lg[(ct * 32 + (g & 3) + 8 * (g >> 2) + 4 * hh) * 64 + nt * 32 + r] = ra[g];
    }
    __syncthreads();
    if (kh == 0) {
#pragma unroll
      for (int g = 0; g < 16; ++g) lg[(ct * 32 + (g & 3) + 8 * (g >> 2) + 4 * hh) * 64 + nt * 32 + r] += ra[g];
    }
    __syncthreads();
  }
  tick(lds, 16);
  int ex1 = 0, ex2 = 0, rk1 = 0, rk2 = 0;
  float wt1 = 0.f, wt2 = 0.f;
  if (tid < 64) {
    float lc[4];
#pragma unroll
    for (int i = 0; i < 4; ++i) lc[i] = lg[i * 64 + tid] + P.b_coarse[i];
    int g = 0; float mx = lc[0];
#pragma unroll
    for (int i = 1; i < 4; ++i) if (lc[i] > mx) { mx = lc[i]; g = i; }
    float den = 0.f;
#pragma unroll
    for (int i = 0; i < 4; ++i) den += __expf(lc[i] - mx);
    const float pg = 1.f / den;
    float sel[8];
#pragma unroll
    for (int i = 0; i < 8; ++i) sel[i] = lg[(4 + g * 8 + i) * 64 + tid] + P.b_fine[g * 8 + i];
    int e1 = 0; float m1 = sel[0];
#pragma unroll
    for (int i = 1; i < 8; ++i) if (sel[i] > m1) { m1 = sel[i]; e1 = i; }
    int e2 = -1; float m2 = -3.0e38f;
#pragma unroll
    for (int i = 0; i < 8; ++i) if (i != e1 && sel[i] > m2) { m2 = sel[i]; e2 = i; }
    const float q2 = __expf(m2 - m1);
    wt1 = pg / (1.f + q2);
    wt2 = pg * q2 / (1.f + q2);
    ex1 = g * 8 + e1; ex2 = g * 8 + e2;
    rk1 = atomicAdd((int*)&hist[ex1], 1);
    rk2 = atomicAdd((int*)&hist[ex2], 1);
  }
  __syncthreads();
  if (tid < 32) {
    const int n = hist[tid];
    int base = 0;
    if (n > 0) base = atomicAdd((int*)(P.ws + OFF_CNT) + tid, n);
    hist[32 + tid] = base;
  }
  __syncthreads();
  if (tid < 64) {
    int* list = (int*)(P.ws + OFF_LIST);
    float* wgt = (float*)(P.ws + OFF_WGT);
    const int t = t0 + tid;
    list[(size_t)ex1 * T + hist[32 + ex1] + rk1] = t * 2;
    list[(size_t)ex2 * T + hist[32 + ex2] + rk2] = t * 2 + 1;
    wgt[t * 2] = wt1;
    wgt[t * 2 + 1] = wt2;
  }
  __syncthreads();
}

constexpr int AS = 520;
__device__ void phase_f_tile(const Params& P, LAS char* lds, const int e, const int row0, const int nrows) {
  int tid_ = threadIdx.x;
  asm volatile("" : "+v"(tid_));
  const int tid = tid_, lane = tid & 63, wave = __builtin_amdgcn_readfirstlane(tid >> 6);
  const int r = lane & 31, hh = lane >> 5;
  LAS _Float16* cc = (LAS _Float16*)(lds + LDS_TILE);
  LAS int* la = (LAS int*)(lds + LDS_RED + 256);
  LAS float* lw = (LAS float*)(lds + LDS_RED + 512);
  if (tid < 64) {
    int a = -1; float w = 0.f;
    if (tid < nrows) { a = ((const int*)(P.ws + OFF_LIST))[(size_t)e * T + row0 + tid]; w = ((const float*)(P.ws + OFF_WGT))[a]; }
    la[tid] = a; lw[tid] = w;
  }
  __syncthreads();
  {
    const _Float16* hb = (const _Float16*)(P.ws + OFF_H);
#pragma unroll 4
    for (int it = 0; it < 16; ++it) {
      const int idx = tid + it * NTHREADS;
      const int row = idx >> 7, ck = idx & 127;
      const int a = la[row];
      half8 v = {(_Float16)0.f, (_Float16)0.f, (_Float16)0.f, (_Float16)0.f, (_Float16)0.f, (_Float16)0.f, (_Float16)0.f, (_Float16)0.f};
      if (a >= 0) v = *(const half8*)(hb + (size_t)(a >> 1) * D + ck * 8);
      *(LAS half8*)(cc + row * XS + ck * 8) = v;
    }
  }
  __syncthreads();
  f32x16 acc[4][2];
  tick(lds, 18);
  zero_acc<4>(acc);
  {
    const _Float16* wg = (const _Float16*)(P.ws + OFF_WG) + (size_t)(e * 16 + wave * 2) * 64 * 512;
    const _Float16* wu = (const _Float16*)(P.ws + OFF_WU) + (size_t)(e * 16 + wave * 2) * 64 * 512;
    const _Float16* const ab[4] = {wg, wg + 64 * 512, wu, wu + 64 * 512};
    gemm_core<4, 4>(ab, lane * 8, 64, cc + r * XS + hh * 8, 32 * XS, acc);
  }
  tick(lds, 19);
  __syncthreads();
  LAS _Float16* at = (LAS _Float16*)(lds + LDS_TILE);
#pragma unroll
  for (int i = 0; i < 2; ++i)
#pragma unroll
    for (int nt = 0; nt < 2; ++nt)
#pragma unroll
      for (int q = 0; q < 4; ++q) {
        half4 hv;
#pragma unroll
        for (int j = 0; j < 4; ++j) hv[j] = (_Float16)(siluf_(acc[i][nt][4 * q + j]) * acc[i + 2][nt][4 * q + j]);
        *(LAS half4*)(at + (nt * 32 + r) * AS + wave * 64 + i * 32 + q * 8 + hh * 4) = hv;
      }
  __syncthreads();
  zero_acc<4>(acc);
  tick(lds, 20);
  {
    const _Float16* wd = (const _Float16*)(P.ws + OFF_WD) + (size_t)(e * 32 + wave * 4) * 32 * 512;
    const _Float16* const ab[4] = {wd, wd + 32 * 512, wd + 2 * 32 * 512, wd + 3 * 32 * 512};
    gemm_core<4, 4>(ab, lane * 8, 32, at + r * AS + hh * 8, 32 * AS, acc);
  }
  tick(lds, 21);
  __syncthreads();
  {
    const float w0 = lw[r], w1 = lw[32 + r];
#pragma unroll
    for (int i = 0; i < 4; ++i)
#pragma unroll
      for (int nt = 0; nt < 2; ++nt)
#pragma unroll
        for (int q = 0; q < 4; ++q) {
          const float w = nt ? w1 : w0;
          half4 hv;
#pragma unroll
          for (int j = 0; j < 4; ++j) hv[j] = (_Float16)(acc[i][nt][4 * q + j] * w);
          *(LAS half4*)(cc + (nt * 32 + r) * XS + (wave * 4 + i) * 32 + q * 8 + hh * 4) = hv;
        }
  }
  __syncthreads();
  {
    _Float16* yb = (_Float16*)(P.ws + OFF_YB);
#pragma unroll 4
    for (int it = 0; it < 16; ++it) {
      const int idx = tid + it * NTHREADS;
      const int row = idx >> 7, ck = idx & 127;
      const int a = la[row];
      if (a >= 0) *(half8*)(yb + (size_t)a * D + ck * 8) = *(const LAS half8*)(cc + row * XS + ck * 8);
    }
  }
  __syncthreads();
}

__device__ void phase_f(const Params& P, LAS char* lds, const unsigned xcc, const unsigned xrank) {
  LAS int* sm = (LAS int*)(lds + LDS_RED);
  const int* counts = (const int*)(P.ws + OFF_CNT);
  if (threadIdx.x == 0) {
    int a = 0;
    for (int e = 0; e < NEXP; ++e) { sm[e] = a; a += (counts[e] + 63) >> 6; }
    sm[32] = a;
  }
  __syncthreads();
  const int total = sm[32];
  int vb = 0;
  for (unsigned x = 0; x < xcc; ++x) vb += (int)__hip_atomic_load((unsigned*)(P.ws + OFF_CNT + 2048) + 16 * x, __ATOMIC_RELAXED, __HIP_MEMORY_SCOPE_AGENT);
  vb += (int)xrank;
  for (int vt = vb; vt < total; vt += gridDim.x) {
    int e = 0;
    for (int i = 1; i < NEXP; ++i) e += (sm[i] <= vt) ? 1 : 0;
    const int row0 = (vt - sm[e]) * 64;
    const int cnt = counts[e];
    const int nrows = (cnt - row0 < 64) ? (cnt - row0) : 64;
    phase_f_tile(P, lds, e, row0, nrows);
  }
}

constexpr int PS = 264;
__device__ void phase_l_tile(const Params& P, LAS char* lds, const int tile) {
  int tid_ = threadIdx.x;
  asm volatile("" : "+v"(tid_));
  const int tid = tid_, lane = tid & 63, wave = __builtin_amdgcn_readfirstlane(tid >> 6);
  const int r = lane & 31, hh = lane >> 5;
  const int t0 = tile * 64;
  LAS _Float16* cc = (LAS _Float16*)(lds + LDS_TILE);
  LAS float* red = (LAS float*)(lds + LDS_RED);
  _Float16* scr = (_Float16*)(P.ws + OFF_Z) + (size_t)blockIdx.x * 16 * NTHREADS * 8;
  {
    LAS _Float16* pt = (LAS _Float16*)(lds + LDS_TILE);
#pragma unroll
    for (int it = 0; it < 8; ++it) {
      const int idx = tid + it * NTHREADS;
      const int row = idx >> 6, c4 = idx & 63;
      const float4 v = *(const float4*)(P.p + (size_t)(t0 + row) * DPLE + c4 * 4);
      half4 hv = {(_Float16)v.x, (_Float16)v.y, (_Float16)v.z, (_Float16)v.w};
      *(LAS half4*)(pt + row * PS + c4 * 4) = hv;
    }
  }
  __syncthreads();
  f32x16 acc[4][2];
  tick(lds, 23);
  zero_acc<4>(acc);
  {
    const _Float16* wp = (const _Float16*)(P.ws + OFF_WPP) + (size_t)(wave * 4) * 16 * 512;
    const _Float16* const ab[4] = {wp, wp + 16 * 512, wp + 2 * 16 * 512, wp + 3 * 16 * 512};
    gemm_core<4, 4>(ab, lane * 8, 16, cc + r * PS + hh * 8, 32 * PS, acc);
  }
#pragma unroll
  for (int i = 0; i < 4; ++i)
#pragma unroll
    for (int nt = 0; nt < 2; ++nt)
#pragma unroll
      for (int hf = 0; hf < 2; ++hf) {
        half8 hv;
#pragma unroll
        for (int j = 0; j < 8; ++j) hv[j] = (_Float16)acc[i][nt][hf * 8 + j];
        *(half8*)(scr + ((size_t)((i * 2 + nt) * 2 + hf) * NTHREADS + tid) * 8) = hv;
      }
  __syncthreads();
  tick(lds, 24);
  {
    const _Float16* hb = (const _Float16*)(P.ws + OFF_H);
    const _Float16* yb = (const _Float16*)(P.ws + OFF_YB);
    float g2[16], b2[16];
#pragma unroll
    for (int hf = 0; hf < 2; ++hf)
#pragma unroll
      for (int j4 = 0; j4 < 2; ++j4) {
        const float4 gv = *(const float4*)(P.ln2_g + hf * 512 + lane * 8 + j4 * 4), bv = *(const float4*)(P.ln2_b + hf * 512 + lane * 8 + j4 * 4);
        g2[hf * 8 + j4 * 4 + 0] = gv.x; g2[hf * 8 + j4 * 4 + 1] = gv.y; g2[hf * 8 + j4 * 4 + 2] = gv.z; g2[hf * 8 + j4 * 4 + 3] = gv.w;
        b2[hf * 8 + j4 * 4 + 0] = bv.x; b2[hf * 8 + j4 * 4 + 1] = bv.y; b2[hf * 8 + j4 * 4 + 2] = bv.z; b2[hf * 8 + j4 * 4 + 3] = bv.w;
      }
#pragma unroll 2
    for (int k = 0; k < 8; ++k) {
      const int row = wave * 8 + k;
      const size_t t = (size_t)(t0 + row);
      float v[16];
      float s = 0.f, ss = 0.f;
#pragma unroll
      for (int hf = 0; hf < 2; ++hf) {
        const half8 hv = *(const half8*)(hb + t * D + hf * 512 + lane * 8);
        const half8 y0 = *(const half8*)(yb + (2 * t) * D + hf * 512 + lane * 8);
        const half8 y1 = *(const half8*)(yb + (2 * t + 1) * D + hf * 512 + lane * 8);
#pragma unroll
        for (int j = 0; j < 8; ++j) {
          const float x = fmaf(ALPHA, (float)hv[j], (float)y0[j] + (float)y1[j]);
          v[hf * 8 + j] = x; s += x; ss = fmaf(x, x, ss);
        }
      }
#pragma unroll
      for (int o = 32; o > 0; o >>= 1) { s += __shfl_xor(s, o); ss += __shfl_xor(ss, o); }
      const float m = s * (1.f / D);
      const float rsd = rsqrtf(fmaxf(ss * (1.f / D) - m * m, 0.f) + EPS);
#pragma unroll
      for (int hf = 0; hf < 2; ++hf) {
        half8 o8;
#pragma unroll
        for (int j = 0; j < 8; ++j) o8[j] = (_Float16)((v[hf * 8 + j] - m) * rsd * g2[hf * 8 + j] + b2[hf * 8 + j]);
        *(LAS half8*)(cc + row * XS + hf * 512 + lane * 8) = o8;
      }
    }
  }
  __syncthreads();
  zero_acc<4>(acc);
  tick(lds, 25);
  {
    const _Float16* wp = (const _Float16*)(P.ws + OFF_WPG) + (size_t)(wave * 4) * 64 * 512;
    const _Float16* const ab[4] = {wp, wp + 64 * 512, wp + 2 * 64 * 512, wp + 3 * 64 * 512};
    gemm_core<4, 2>(ab, lane * 8, 64, cc + r * XS + hh * 8, 32 * XS, acc);
  }
  tick(lds, 26);
#pragma unroll
  for (int i = 0; i < 4; ++i)
#pragma unroll
    for (int nt = 0; nt < 2; ++nt)
#pragma unroll
      for (int hf = 0; hf < 2; ++hf) {
        const half8 pv = *(const half8*)(scr + ((size_t)((i * 2 + nt) * 2 + hf) * NTHREADS + tid) * 8);
#pragma unroll
        for (int q2 = 0; q2 < 2; ++q2) {
          const int q = hf * 2 + q2;
          const half4 yv = *(const LAS half4*)(cc + (nt * 32 + r) * XS + (wave * 4 + i) * 32 + q * 8 + hh * 4);
#pragma unroll
          for (int j = 0; j < 4; ++j) {
            const float gate = sigmoidf_(acc[i][nt][4 * q + j]);
            acc[i][nt][4 * q + j] = fmaf(ALPHA, (float)yv[j], (float)pv[q2 * 4 + j] * gate);
          }
        }
      }
  float mu[2], rs[2];
  ln_stats(acc, red, wave, lane, mu, rs);
  tick(lds, 27);
#pragma unroll
  for (int i = 0; i < 4; ++i)
#pragma unroll
    for (int q = 0; q < 4; ++q) {
      const int ch0 = (wave * 4 + i) * 32 + q * 8 + hh * 4;
      const float4 gv = *(const float4*)(P.ln3_g + ch0), bv = *(const float4*)(P.ln3_b + ch0);
#pragma unroll
      for (int nt = 0; nt < 2; ++nt) {
        float4 o;
        o.x = (acc[i][nt][4 * q + 0] - mu[nt]) * rs[nt] * gv.x + bv.x;
        o.y = (acc[i][nt][4 * q + 1] - mu[nt]) * rs[nt] * gv.y + bv.y;
        o.z = (acc[i][nt][4 * q + 2] - mu[nt]) * rs[nt] * gv.z + bv.z;
        o.w = (acc[i][nt][4 * q + 3] - mu[nt]) * rs[nt] * gv.w + bv.w;
        *(float4*)(P.out + (size_t)(t0 + nt * 32 + r) * D + ch0) = o;
      }
    }
  __syncthreads();
}

#define XB_TMO      128
#define XB_XCNT(j)  (256  + 64 * (j))
#define XB_XSUB(j)  (1280 + 64 * (j))
#define XB_XGEN(j)  (2304 + 64 * (j))
#define XB_TOP      3328
#define XB_TOPGEN   3392
#define XCD_BAR_WORDS 3456
#define XB_SPIN_CAP (1u << 18)
__device__ __forceinline__ unsigned xb_ld(unsigned* p)              { return __hip_atomic_load(p, __ATOMIC_RELAXED, __HIP_MEMORY_SCOPE_AGENT); }
__device__ __forceinline__ unsigned xb_add(unsigned* p, unsigned v) { return __hip_atomic_fetch_add(p, v, __ATOMIC_RELAXED, __HIP_MEMORY_SCOPE_AGENT); }
__device__ __forceinline__ unsigned xb_xcc_id() { return (unsigned)__builtin_amdgcn_s_getreg((3 << 11) | 20) & 0xFu; }
#define XB_SPIN(cond, bar) do { unsigned _sp = 0; while (cond) { __builtin_amdgcn_s_sleep(1); \
    if ((++_sp & 255u) == 0u) { if (xb_ld(&(bar)[XB_TMO])) break; if (_sp > XB_SPIN_CAP) { atomicAdd(&(bar)[XB_TMO], 1u); break; } } } } while (0)
struct XcdBarrier { unsigned* bar; unsigned x; volatile LAS unsigned* st; };
__device__ __forceinline__ XcdBarrier xcd_barrier_post(unsigned* bar, volatile LAS unsigned* st) {
  XcdBarrier b; b.bar = bar; b.x = xb_xcc_id(); b.st = st;
  if (threadIdx.x == 0) (void)xb_add(&bar[XB_XCNT(b.x)], 1u);
  return b;
}
__device__ __forceinline__ void xcd_barrier_complete(unsigned* bar, unsigned x, unsigned& nloc, unsigned& nx) {
  const unsigned G = gridDim.x * gridDim.y * gridDim.z;
  unsigned sum, cnt, mine, sp = 0u;
  for (;;) {
    sum = 0u; cnt = 0u; mine = 0u;
#pragma unroll
    for (unsigned j = 0; j < 16; ++j) { const unsigned c = xb_ld(&bar[XB_XCNT(j)]); sum += c; cnt += (c > 0u) ? 1u : 0u; mine = (j == x) ? c : mine; }
    if (sum == G) break;
    __builtin_amdgcn_s_sleep(1);
    if ((++sp & 255u) == 0u) { if (xb_ld(&bar[XB_TMO])) break; if (sp > XB_SPIN_CAP) { atomicAdd(&bar[XB_TMO], 1u); break; } }
  }
  nloc = mine > 0u ? mine : 1u; nx = cnt > 0u ? cnt : 1u;
}
__device__ __forceinline__ void xcd_barrier(const XcdBarrier& b) {
  asm volatile("s_waitcnt vmcnt(0)" ::: "memory");
  __syncthreads();
  if (threadIdx.x == 0) {
    unsigned* bar = b.bar;
    __builtin_amdgcn_s_waitcnt(0);
    unsigned nloc = b.st[0], nx = b.st[1];
    if (nloc == 0u) { xcd_barrier_complete(bar, b.x, nloc, nx); b.st[0] = nloc; b.st[1] = nx; }
    const unsigned old = xb_add(&bar[XB_XSUB(b.x)], 1u);
    const unsigned gen = old / nloc;
    if (old + 1u == (gen + 1u) * nloc) {
      __builtin_amdgcn_fence(__ATOMIC_RELEASE, "agent");
      asm volatile("s_waitcnt vmcnt(0)" ::: "memory");
      const unsigned og = xb_add(&bar[XB_TOP], 1u);
      const unsigned tg = og / nx;
      if (og + 1u == (tg + 1u) * nx) xb_add(&bar[XB_TOPGEN], 1u);
      else XB_SPIN(xb_ld(&bar[XB_TOPGEN]) == tg, bar);
      __builtin_amdgcn_fence(__ATOMIC_ACQUIRE, "agent");
      xb_add(&bar[XB_XGEN(b.x)], 1u);
      asm volatile("s_waitcnt vmcnt(0)" ::: "memory");
    } else {
      XB_SPIN(xb_ld(&bar[XB_XGEN(b.x)]) == gen, bar);
      __builtin_amdgcn_fence(__ATOMIC_ACQUIRE, "agent");
      asm volatile("s_waitcnt vmcnt(0)" ::: "memory");
    }
  }
  __syncthreads();
}

__global__ void __launch_bounds__(NTHREADS) k_mega(Params P) {
  extern __shared__ __attribute__((aligned(16))) char lds_raw[];
  LAS char* lds = (LAS char*)lds_raw;
  if (threadIdx.x < 4) ((LAS unsigned*)(lds + LDS_BAR))[threadIdx.x] = 0u;
  __syncthreads();
  if (PROBE_ON && threadIdx.x < 64) ((LAS unsigned long long*)(lds + LDS_PROF))[threadIdx.x] = 0ull;
  if (PROBE_ON) __syncthreads();
  if (PROBE_ON && blockIdx.x == 0 && threadIdx.x == 448) ((LAS unsigned long long*)(lds + LDS_PROF))[0] = __builtin_amdgcn_s_memrealtime();
  const XcdBarrier bar = xcd_barrier_post((unsigned*)(P.ws + OFF_BAR), (volatile LAS unsigned*)(lds + LDS_BAR));
  if (threadIdx.x == 0) ((LAS unsigned*)(lds + LDS_BAR))[2] = xb_add((unsigned*)(P.ws + OFF_CNT + 2048) + 16 * bar.x, 1u);
  phase_pack(P);
  tick(lds, 0);
  xcd_barrier(bar);
  tick(lds, 1);
  int pack_j = 0;
  for (int tile = blockIdx.x; tile < NTILES; tile += gridDim.x) phase_z_tile(P, lds, tile, false);
  tick(lds, 12);
  xcd_barrier(bar);
  tick(lds, 3);
  {
    const int ustride = gridDim.x * NTHREADS;
    const int ntb = (NTILES - 1 - (int)blockIdx.x) / (int)gridDim.x;
    for (int tile = blockIdx.x + ntb * gridDim.x; tile >= (int)blockIdx.x; tile -= gridDim.x) phase_m_tile(P, lds, tile, pack_j);
    for (int u = pack_j * ustride + blockIdx.x * NTHREADS + threadIdx.x; u < PACK_UNITS; u += 3 * ustride) {
      float pv[3][8];
      pack_issue(P, u, ustride, pv);
      pack_commit(P, u, ustride, pv);
    }
  }
  tick(lds, 17);
  xcd_barrier(bar);
  tick(lds, 5);
  phase_f(P, lds, bar.x, ((LAS unsigned*)(lds + LDS_BAR))[2]);
  tick(lds, 22);
  xcd_barrier(bar);
  tick(lds, 7);
  for (int tile = blockIdx.x; tile < NTILES; tile += gridDim.x) phase_l_tile(P, lds, tile);
  tick(lds, 28);
  if (PROBE_ON && blockIdx.x == 0) {
    if (threadIdx.x == 448) {
      LAS unsigned long long* pf = (LAS unsigned long long*)(lds + LDS_PROF);
      unsigned long long d = 0;
      for (int k = 0; k < 40; ++k) if ((PROBE_MASK >> k) & 1ull) d += pf[1 + k];
      d *= PROBE_MULT;
      const unsigned long long t_end = __builtin_amdgcn_s_memrealtime();
      while (__builtin_amdgcn_s_memrealtime() - t_end < d) __builtin_amdgcn_s_sleep(8);
    }
    __syncthreads();
  }
}
}

static Params make_params(void* const* d_in, void* d_out, void* d_ws) {
  Params P{};
  const float** f = (const float**)&P;
  for (int i = 0; i < 25; ++i) f[i] = (const float*)d_in[i];
  P.out = (float*)d_out;
  P.ws = (char*)d_ws;
  return P;
}

extern "C" void kernel_launch(void* const* d_in, const int* in_sizes, int n_in, void* d_out, int out_size, void* d_ws, size_t ws_size, hipStream_t stream) {
  static int grid = 0;
  if (grid == 0) {
    if (ws_size < OFF_END || n_in != 25) { fprintf(stderr, "kernel_launch: bad ws/n_in: %zu < %zu, n_in %d\n", ws_size, (size_t)OFF_END, n_in); grid = -1; return; }
    int dev = 0, cus = 0, per_cu = 0;
    (void)hipGetDevice(&dev);
    (void)hipDeviceGetAttribute(&cus, hipDeviceAttributeMultiprocessorCount, dev);
    (void)hipFuncSetAttribute((const void*)k_mega, hipFuncAttributeMaxDynamicSharedMemorySize, LDS_BYTES);
    (void)hipOccupancyMaxActiveBlocksPerMultiprocessor(&per_cu, (const void*)k_mega, NTHREADS, LDS_BYTES);
    if (per_cu < 1) { fprintf(stderr, "kernel_launch: occupancy query says %d blocks/CU\n", per_cu); }
    (void)hipGetLastError();
    grid = cus;
  }
  if (grid < 0) return;
  (void)hipMemsetAsync(d_ws, 0, CTRL_BYTES, stream);
  Params P = make_params(d_in, d_out, d_ws);
  void* args[] = {&P};
  hipError_t e = hipLaunchCooperativeKernel((const void*)k_mega, dim3(grid), dim3(NTHREADS), args, LDS_BYTES, stream);
  if (e != hipSuccess) fprintf(stderr, "kernel_launch: cooperative launch failed: %s (grid %d)\n", hipGetErrorString(e), grid);
}
```

```cpp
#include <hip/hip_runtime.h>
#include <hip/hip_fp16.h>
#include <cstdio>
#include <cstdint>

namespace {
constexpr int T = 32768, SEQ = 8192, D = 1024, DIN = 1536, DPOOL = 512, DCONV = 512, DEXP = 512, DPLE = 256;
constexpr int NEXP = 32, CW = 31;
constexpr float ALPHA = 1.189207115002721f;
constexpr float EPS = 1e-5f;
constexpr int NTHREADS = 512;
constexpr int NTILES = T / 64;
constexpr int XS = 1032;

constexpr int LDS_TILE = 0;
constexpr int LDS_AUX = 64 * XS * 2;
constexpr int LDS_RED = LDS_AUX + 25600;
constexpr int LDS_BAR = LDS_RED + 4096;
constexpr int LDS_BYTES = LDS_BAR + 16 + (512);
typedef _Float16 half8 __attribute__((ext_vector_type(8)));
typedef _Float16 half4 __attribute__((ext_vector_type(4)));
typedef _Float16 half2v __attribute__((ext_vector_type(2)));
typedef float f32x16 __attribute__((ext_vector_type(16)));
#define LAS __attribute__((address_space(3)))
#define MFMA(a, b, c) __builtin_amdgcn_mfma_f32_32x32x16_f16((a), (b), (c), 0, 0, 0)

constexpr size_t OFF_BAR  = 0;
constexpr size_t OFF_CNT  = 16384;
constexpr size_t CTRL_BYTES = 20480;
constexpr size_t OFF_LIST = CTRL_BYTES;
constexpr size_t OFF_WGT  = OFF_LIST + (size_t)NEXP * T * 4;
constexpr size_t OFF_WIN  = OFF_WGT + (size_t)2 * T * 4;
constexpr size_t OFF_WOUT = OFF_WIN + (size_t)DIN * D * 2;
constexpr size_t OFF_WR   = OFF_WOUT + (size_t)D * D * 2;
constexpr size_t OFF_WG   = OFF_WR + (size_t)64 * D * 2;
constexpr size_t OFF_WU   = OFF_WG + (size_t)NEXP * D * DEXP * 2;
constexpr size_t OFF_WD   = OFF_WU + (size_t)NEXP * D * DEXP * 2;
constexpr size_t OFF_WPP  = OFF_WD + (size_t)NEXP * D * DEXP * 2;
constexpr size_t OFF_WPG  = OFF_WPP + (size_t)DPLE * D * 2;
constexpr size_t OFF_Z    = OFF_WPG + (size_t)D * D * 2;
constexpr size_t OFF_CC   = OFF_Z + (size_t)T * DIN * 2;
constexpr size_t OFF_H    = OFF_CC + (size_t)T * D * 2;
constexpr size_t OFF_YB   = OFF_H + (size_t)T * D * 2;
constexpr size_t OFF_END  = OFF_YB + (size_t)2 * T * D * 2;

struct Params {
  const float *x, *p, *w_in, *w_pool_mix, *pool_scale, *w_dw, *b_dw, *conv_ln_g, *conv_ln_b, *w_out, *ln1_g, *ln1_b, *w_coarse, *b_coarse, *w_fine,
      *b_fine, *w_gate, *w_up, *w_down, *ln2_g, *ln2_b, *w_ple_proj, *w_ple_gate, *ln3_g, *ln3_b;
  float* out;
  char* ws;
};

__device__ __forceinline__ float sigmoidf_(float x) { return __builtin_amdgcn_rcpf(1.f + __expf(-x)); }
__device__ __forceinline__ float siluf_(float x) { return x * __builtin_amdgcn_rcpf(1.f + __expf(-x)); }


#ifndef PROBE_ON
#define PROBE_ON 0
#define PROBE_MASK 0ull
#endif
#define PROBE_MULT 1
#define LDS_PROF (LDS_BYTES - 512)
__device__ __forceinline__ void tick(LAS char* lds, const int k) {
  if (PROBE_ON && blockIdx.x == 0 && threadIdx.x == 448) {
    LAS unsigned long long* pf = (LAS unsigned long long*)(lds + LDS_PROF);
    const unsigned long long now = __builtin_amdgcn_s_memrealtime();
    pf[1 + k] += now - pf[0];
    pf[0] = now;
  }
}
template <class F>
__device__ __forceinline__ void pack_mat(_Float16* __restrict__ dst, const int NB, const int K, const int N, F src, const int gtid, const int gth) {
  const int KT = K / 16, MT = N / 32;
  const int total = NB * MT * KT * 64;
  for (int idx = gtid; idx < total; idx += gth) {
    const int lane = idx & 63;
    int f = idx >> 6;
    const int kt = f % KT; f /= KT;
    const int mt = f % MT; const int b = f / MT;
    const int k0 = kt * 16 + (lane >> 5) * 8, n = mt * 32 + (lane & 31);
    half8 v;
#pragma unroll
    for (int j = 0; j < 8; ++j) v[j] = (_Float16)src(b, k0 + j, n);
    *(half8*)(dst + (size_t)idx * 8) = v;
  }
}

__device__ void phase_pack(const Params& P) {
  const int gtid = blockIdx.x * NTHREADS + threadIdx.x, gth = gridDim.x * NTHREADS;
  char* ws = P.ws;
  {
    _Float16* dst = (_Float16*)(ws + OFF_WIN);
    const int total = 48 * 64 * 64;
    for (int idx = gtid; idx < total; idx += gth) {
      const int lane = idx & 63;
      const int f = idx >> 6;
      const int kt = f & 63, mt = f >> 6;
      const int k0 = kt * 16 + (lane >> 5) * 8, n = mt * 32 + (lane & 31);
      half8 v;
      if (mt >= 16) {
#pragma unroll
        for (int j = 0; j < 8; ++j) v[j] = (_Float16)P.w_in[(size_t)(k0 + j) * DIN + n];
      } else {
        const int g = n >> 7, d = n & 127;
        float acc[8];
#pragma unroll
        for (int j = 0; j < 8; ++j) acc[j] = 0.f;
        const float* wpm = P.w_pool_mix + (size_t)g * 128 * 128 + d;
        const float* wi = P.w_in + (size_t)k0 * DIN + g * 128;
#pragma unroll 8
        for (int c = 0; c < 128; ++c) {
          const float m = wpm[c * 128];
#pragma unroll
          for (int j = 0; j < 8; ++j) acc[j] = fmaf(wi[(size_t)j * DIN + c], m, acc[j]);
        }
        const float sc = P.pool_scale[n];
#pragma unroll
        for (int j = 0; j < 8; ++j) v[j] = (_Float16)(acc[j] * sc);
      }
      *(half8*)(dst + (size_t)idx * 8) = v;
    }
  }
  pack_mat((_Float16*)(ws + OFF_WOUT), 1, D, D, [&](int, int k, int n) { return P.w_out[(size_t)k * D + n]; }, gtid, gth);
  pack_mat((_Float16*)(ws + OFF_WR), 1, D, 64, [&](int, int k, int n) { return n < 4 ? P.w_coarse[k * 4 + n] : (n < 36 ? P.w_fine[k * 32 + n - 4] : 0.f); }, gtid, gth);
  pack_mat((_Float16*)(ws + OFF_WPP), 1, DPLE, D, [&](int, int k, int n) { return P.w_ple_proj[(size_t)k * D + n]; }, gtid, gth);
  pack_mat((_Float16*)(ws + OFF_WPG), 1, D, D, [&](int, int k, int n) { return P.w_ple_gate[(size_t)k * D + n]; }, gtid, gth);
}

template <int NA, int PF>
__device__ __forceinline__ void gemm_core(const _Float16* const (&ab)[NA], const int lane_off, const int KT,
                                          const LAS _Float16* bp, const int nt_stride, f32x16 (&acc)[NA][2]) {
  half8 abuf[PF][NA];
#pragma unroll
  for (int s = 0; s < PF; ++s)
#pragma unroll
    for (int i = 0; i < NA; ++i) abuf[s][i] = *(const half8*)(ab[i] + s * 512 + lane_off);
  half8 bb[2][2];
  bb[0][0] = *(const LAS half8*)(bp);
  bb[0][1] = *(const LAS half8*)(bp + nt_stride);
#pragma unroll 1
  for (int kt = 0; kt < KT; kt += PF) {
#pragma unroll
    for (int s = 0; s < PF; ++s) {
      const int k = kt + s;
      const int kb = (k + 1 < KT) ? (k + 1) : (KT - 1);
      bb[(s + 1) & 1][0] = *(const LAS half8*)(bp + kb * 16);
      bb[(s + 1) & 1][1] = *(const LAS half8*)(bp + nt_stride + kb * 16);
      __builtin_amdgcn_sched_barrier(0);
#pragma unroll
      for (int i = 0; i < NA; ++i) {
        acc[i][0] = MFMA(abuf[s][i], bb[s & 1][0], acc[i][0]);
        acc[i][1] = MFMA(abuf[s][i], bb[s & 1][1], acc[i][1]);
      }
      const int kn = (k + PF < KT) ? (k + PF) : (KT - 1);
#pragma unroll
      for (int i = 0; i < NA; ++i) abuf[s][i] = *(const half8*)(ab[i] + kn * 512 + lane_off);
      __builtin_amdgcn_sched_barrier(0);
    }
  }
}

template <int NA>
__device__ __forceinline__ void zero_acc(f32x16 (&acc)[NA][2]) {
#pragma unroll
  for (int i = 0; i < NA; ++i)
#pragma unroll
    for (int n = 0; n < 2; ++n)
#pragma unroll
      for (int r = 0; r < 16; ++r) acc[i][n][r] = 0.f;
}

constexpr int PACK_UNITS = 3 << 21;
__device__ __forceinline__ void pack_issue(const Params& P, const int u0, const int ustride, float (&pv)[3][8]) {
#pragma unroll
  for (int q = 0; q < 3; ++q) {
    const int u = u0 + q * ustride;
    if (u < PACK_UNITS) {
      const int m = u >> 21, idx = u & ((1 << 21) - 1), lane = idx & 63, f = idx >> 6, e = f >> 10;
      const int r = lane & 31, hh = lane >> 5;
      const float* src;
      int stride;
      if (m < 2) {
        const int kt = f & 63, mt = (f >> 6) & 15;
        src = (m == 0 ? P.w_gate : P.w_up) + ((size_t)e * D + kt * 16 + hh * 8) * DEXP + mt * 32 + r;
        stride = DEXP;
      } else {
        const int kt = f & 31, mt = (f >> 5) & 31;
        src = P.w_down + ((size_t)e * DEXP + kt * 16 + hh * 8) * D + mt * 32 + r;
        stride = D;
      }
#pragma unroll
      for (int j = 0; j < 8; ++j) pv[q][j] = src[(size_t)j * stride];
    }
  }
}
__device__ __forceinline__ void pack_commit(const Params& P, const int u0, const int ustride, const float (&pv)[3][8]) {
#pragma unroll
  for (int q = 0; q < 3; ++q) {
    const int u = u0 + q * ustride;
    if (u < PACK_UNITS) {
      half8 v;
#pragma unroll
      for (int j = 0; j < 8; ++j) v[j] = (_Float16)pv[q][j];
      *(half8*)((_Float16*)(P.ws + OFF_WG) + (size_t)u * 8) = v;
    }
  }
}

__device__ void pack_experts_all(const Params& P) {
  const int ustride = gridDim.x * NTHREADS;
  int u = blockIdx.x * NTHREADS + threadIdx.x;
  float pa[3][8], pb[3][8];
  pack_issue(P, u, ustride, pa);
#pragma unroll 1
  for (; u < PACK_UNITS; u += 6 * ustride) {
    pack_issue(P, u + 3 * ustride, ustride, pb);
    pack_commit(P, u, ustride, pa);
    pack_issue(P, u + 6 * ustride, ustride, pa);
    pack_commit(P, u + 3 * ustride, ustride, pb);
  }
}

__device__ __forceinline__ void z_x_issue(const Params& P, const int tile, float4 (&xv)[32]) {
  const int tid = threadIdx.x;
#pragma unroll
  for (int it = 0; it < 32; ++it) {
    const int idx = tid + it * NTHREADS;
    xv[it] = *(const float4*)(P.x + (size_t)(tile * 64 + (idx >> 8)) * D + (idx & 255) * 4);
  }
}
__device__ __forceinline__ void z_x_commit(LAS char* lds, const float4 (&xv)[32]) {
  const int tid = threadIdx.x;
  LAS _Float16* xt = (LAS _Float16*)lds;
#pragma unroll
  for (int it = 0; it < 32; ++it) {
    const int idx = tid + it * NTHREADS;
    const half4 hv = {(_Float16)xv[it].x, (_Float16)xv[it].y, (_Float16)xv[it].z, (_Float16)xv[it].w};
    *(LAS half4*)(xt + (idx >> 8) * XS + (idx & 255) * 4) = hv;
  }
}
__device__ void phase_z_tile(const Params& P, LAS char* lds, const int tile, const bool preloaded) {
  const int tid = threadIdx.x, lane = tid & 63, wave = __builtin_amdgcn_readfirstlane(tid >> 6);
  const int r = lane & 31, hh = lane >> 5;
  LAS _Float16* xt = (LAS _Float16*)lds;
  const int t0 = tile * 64;
  if (!preloaded) {
#pragma unroll 8
    for (int it = 0; it < 32; ++it) {
      const int idx = tid + it * NTHREADS;
      const int row = idx >> 8, c4 = idx & 255;
      const float4 v = *(const float4*)(P.x + (size_t)(t0 + row) * D + c4 * 4);
      half4 hv = {(_Float16)v.x, (_Float16)v.y, (_Float16)v.z, (_Float16)v.w};
      *(LAS half4*)(xt + row * XS + c4 * 4) = hv;
    }
  }
  __syncthreads();
  tick(lds, 10);
  {
    _Float16* xc = (_Float16*)(P.ws + OFF_CC) + (size_t)(tile * 8 + wave) * 16 * 512;
#pragma unroll
    for (int i = 0; i < 4; ++i)
#pragma unroll
      for (int nt = 0; nt < 2; ++nt)
#pragma unroll
        for (int qp = 0; qp < 2; ++qp) {
          const LAS _Float16* src = xt + (nt * 32 + r) * XS + (wave * 4 + i) * 32 + qp * 16 + hh * 4;
          const half4 lo = *(const LAS half4*)(src), hi = *(const LAS half4*)(src + 8);
          const half8 v = {lo[0], lo[1], lo[2], lo[3], hi[0], hi[1], hi[2], hi[3]};
          *(half8*)(xc + ((i * 2 + nt) * 2 + qp) * 512 + lane * 8) = v;
        }
  }
  tick(lds, 9);
  const _Float16* wp = (const _Float16*)(P.ws + OFF_WIN);
  _Float16* zN = (_Float16*)(P.ws + OFF_Z);
  const LAS _Float16* bp = xt + r * XS + hh * 8;
#pragma unroll 1
  for (int pass = 0; pass < 2; ++pass) {
    f32x16 acc[3][2];
    zero_acc<3>(acc);
    const int mt0 = pass * 24 + wave * 3;
    const _Float16* const ab[3] = {wp + (size_t)mt0 * 64 * 512, wp + (size_t)(mt0 + 1) * 64 * 512, wp + (size_t)(mt0 + 2) * 64 * 512};
    gemm_core<3, 4>(ab, lane * 8, 64, bp, 32 * XS, acc);
    tick(lds, 11);
#pragma unroll
    for (int i = 0; i < 3; ++i)
#pragma unroll
      for (int nt = 0; nt < 2; ++nt)
#pragma unroll
        for (int q = 0; q < 4; ++q) {
          half4 hv = {(_Float16)acc[i][nt][4 * q], (_Float16)acc[i][nt][4 * q + 1], (_Float16)acc[i][nt][4 * q + 2], (_Float16)acc[i][nt][4 * q + 3]};
          const size_t off = ((((size_t)tile * 48 + (mt0 + i)) * 2 + nt) * 4 + q) * 256 + lane * 4;
          *(half4*)(zN + off) = hv;
        }
  }
  __syncthreads();
}


__device__ __forceinline__ void ln_stats(const f32x16 (&v)[4][2], LAS float* red, const int wave, const int lane, float (&mu)[2], float (&rs)[2]) {
  const int r = lane & 31, hh = lane >> 5;
#pragma unroll
  for (int nt = 0; nt < 2; ++nt) {
    float s = 0.f, ss = 0.f;
#pragma unroll
    for (int i = 0; i < 4; ++i)
#pragma unroll
      for (int g = 0; g < 16; ++g) { const float x = v[i][nt][g]; s += x; ss = fmaf(x, x, ss); }
    s += __shfl_xor(s, 32);
    ss += __shfl_xor(ss, 32);
    if (hh == 0) { red[(wave * 64 + nt * 32 + r) * 2] = s; red[(wave * 64 + nt * 32 + r) * 2 + 1] = ss; }
  }
  __syncthreads();
#pragma unroll
  for (int nt = 0; nt < 2; ++nt) {
    float s = 0.f, ss = 0.f;
#pragma unroll
    for (int w = 0; w < 8; ++w) { s += red[(w * 64 + nt * 32 + r) * 2]; ss += red[(w * 64 + nt * 32 + r) * 2 + 1]; }
    const float m = s * (1.f / D);
    const float var = fmaxf(ss * (1.f / D) - m * m, 0.f);
    mu[nt] = m;
    rs[nt] = rsqrtf(var + EPS);
  }
}


constexpr int RS = 100;
constexpr int WST_BYTES = 16 * RS * 2;
__device__ __forceinline__ void fill_issue_w(const _Float16* __restrict__ zN, const int tile, const int g, const bool has_prev, const int wave, const int lane,
                                             half4 (&za)[6], half4 (&zb)[6]) {
  const bool glu = g >= 4;
  const int mtl = (glu ? 16 + (g - 4) * 4 : g * 4) + (wave >> 1), q0 = (wave & 1) * 2;
#pragma unroll
  for (int uu = 0; uu < 6; ++uu) {
    const int st = uu >> 1, q = q0 + (uu & 1);
    const int ztile = (st == 0) ? tile - 1 : tile;
    const int nt = (st == 0) ? 1 : st - 1;
    const half4 z0 = {(_Float16)0.f, (_Float16)0.f, (_Float16)0.f, (_Float16)0.f};
    za[uu] = z0; zb[uu] = z0;
    if (st != 0 || has_prev) {
      const size_t off = ((((size_t)ztile * 48 + mtl) * 2 + nt) * 4 + q) * 256 + lane * 4;
      za[uu] = *(const half4*)(zN + off);
      if (glu) zb[uu] = *(const half4*)(zN + off + (size_t)16 * 2 * 4 * 256);
    }
  }
}
__device__ __forceinline__ void fill_commit_w(LAS _Float16* wst, const bool glu, const int lane, const half4 (&za)[6], const half4 (&zb)[6]) {
  const int r = lane & 31, hh = lane >> 5;
#pragma unroll
  for (int uu = 0; uu < 6; ++uu) {
    const int st = uu >> 1, qq = uu & 1;
#pragma unroll
    for (int e = 0; e < 4; ++e) {
      float v = (float)za[uu][e];
      if (glu) v *= sigmoidf_((float)zb[uu][e]);
      wst[(qq * 8 + hh * 4 + e) * RS + st * 32 + r] = (_Float16)v;
    }
  }
}
__device__ __forceinline__ float seg16_treduce(const float (&v)[16]) {
  const int lane = threadIdx.x & 63;
  float a8[8], a4[4], a2[2];
  {
    const bool up = (lane & 8) != 0;
#pragma unroll
    for (int i = 0; i < 8; ++i) { const float keep = up ? v[i + 8] : v[i], send = up ? v[i] : v[i + 8]; a8[i] = keep + __shfl_xor(send, 8); }
  }
  {
    const bool up = (lane & 4) != 0;
#pragma unroll
    for (int i = 0; i < 4; ++i) { const float keep = up ? a8[i + 4] : a8[i], send = up ? a8[i] : a8[i + 4]; a4[i] = keep + __shfl_xor(send, 4); }
  }
  {
    const bool up = (lane & 2) != 0;
#pragma unroll
    for (int i = 0; i < 2; ++i) { const float keep = up ? a4[i + 2] : a4[i], send = up ? a4[i] : a4[i + 2]; a2[i] = keep + __shfl_xor(send, 2); }
  }
  const bool up = (lane & 1) != 0;
  const float keep = up ? a2[1] : a2[0], send = up ? a2[0] : a2[1];
  return keep + __shfl_xor(send, 1);
}
template <int W>
__device__ __forceinline__ void pool_group_w(const LAS _Float16* wst, LAS _Float16* cc, const int g, const int s0, const int wave, const int lane) {
  const int c = lane & 15, tg = lane >> 4;
  float v[32];
#pragma unroll
  for (int i = 0; i < 16; ++i) {
    const half2v p = *(const LAS half2v*)(wst + c * RS + 16 + tg * 16 + 2 * i);
    v[2 * i] = (float)p[0]; v[2 * i + 1] = (float)p[1];
  }
  float S = 0.f;
#pragma unroll
  for (int i = 0; i < W; ++i) S += v[16 - i];
#pragma unroll
  for (int j = 0; j < 16; ++j) {
    if (j > 0) S += v[16 + j] - v[16 + j - W];
    const int s = s0 + tg * 16 + j;
    const int cnt = (s + 1 < W) ? (s + 1) : W;
    const float o = S * __builtin_amdgcn_rcpf((float)cnt) - v[16 + j];
    cc[(tg * 16 + j) * XS + g * 128 + wave * 16 + c] = (_Float16)o;
  }
}

__device__ void phase_m_tile(const Params& P, LAS char* lds, const int tile) {
  int tid_ = threadIdx.x;
  asm volatile("" : "+v"(tid_));
  const int tid = tid_, lane = tid & 63, wave = __builtin_amdgcn_readfirstlane(tid >> 6);
  const int r = lane & 31, hh = lane >> 5;
  const int t0 = tile * 64;
  const int s0 = t0 % SEQ;
  const bool has_prev = (s0 != 0);
  const _Float16* zN = (const _Float16*)(P.ws + OFF_Z);
  LAS _Float16* cc = (LAS _Float16*)(lds + LDS_TILE);
  LAS _Float16* ub = (LAS _Float16*)(lds + LDS_AUX);
  LAS float* red = (LAS float*)(lds + LDS_RED);

  const int ustride = gridDim.x * NTHREADS;
  LAS _Float16* wst = (LAS _Float16*)(lds + LDS_AUX + wave * WST_BYTES);
  const int c16 = lane & 15, tg = lane >> 4;
  half4 za[6], zb[6];
  fill_issue_w(zN, tile, 0, has_prev, wave, lane, za, zb);
#pragma unroll 1
  for (int g = 0; g < 8; ++g) {
    const bool glu = g >= 4;
    const int hd = g - 4, ch = (glu ? hd : 0) * 128 + wave * 16 + c16;
    fill_commit_w(wst, glu, lane, za, zb);
    if (g < 7) fill_issue_w(zN, tile, g + 1, has_prev, wave, lane, za, zb);
    float wv[CW];
    float bias = 0.f, g_ = 0.f, b_ = 0.f;
    if (glu) {
#pragma unroll
      for (int jj = 0; jj < CW; ++jj) wv[jj] = P.w_dw[jj * DCONV + ch];
      bias = P.b_dw[ch]; g_ = P.conv_ln_g[ch]; b_ = P.conv_ln_b[ch];
    } else {
#pragma unroll
      for (int jj = 0; jj < CW; ++jj) wv[jj] = 0.f;
    }
    if (!glu) {
      if (g == 0) pool_group_w<2>(wst, cc, 0, s0, wave, lane);
      else if (g == 1) pool_group_w<4>(wst, cc, 1, s0, wave, lane);
      else if (g == 2) pool_group_w<8>(wst, cc, 2, s0, wave, lane);
      else pool_group_w<16>(wst, cc, 3, s0, wave, lane);
    } else {
      float y[16];
      {
        float uv[46];
#pragma unroll
        for (int i = 0; i < 23; ++i) {
          const half2v p = *(const LAS half2v*)(wst + c16 * RS + tg * 16 + 2 + 2 * i);
          uv[2 * i] = (float)p[0]; uv[2 * i + 1] = (float)p[1];
        }
#pragma unroll
        for (int j = 0; j < 16; ++j) y[j] = bias;
#pragma unroll
        for (int jj = 0; jj < CW; ++jj) {
#pragma unroll
          for (int j = 0; j < 16; ++j) y[j] = fmaf(wv[jj], uv[j + jj], y[j]);
        }
      }
      float t1, t2;
      {
        float sq[16];
#pragma unroll
        for (int j = 0; j < 16; ++j) sq[j] = y[j] * y[j];
        t1 = seg16_treduce(y);
        t2 = seg16_treduce(sq);
      }
      __syncthreads();
      red[(wave * 64 + lane) * 2] = t1;
      red[(wave * 64 + lane) * 2 + 1] = t2;
      __syncthreads();
      float s1 = 0.f, s2 = 0.f;
#pragma unroll
      for (int w = 0; w < 8; ++w) { s1 += red[(w * 64 + lane) * 2]; s2 += red[(w * 64 + lane) * 2 + 1]; }
      const float m_l = s1 * (1.f / 128.f);
      const float r_l = rsqrtf(fmaxf(s2 * (1.f / 128.f) - m_l * m_l, 0.f) + EPS);
#pragma unroll
      for (int j = 0; j < 16; ++j) {
        const float m = __shfl(m_l, tg * 16 + j), rsd = __shfl(r_l, tg * 16 + j);
        const float v = (y[j] - m) * rsd * g_ + b_;
        cc[(tg * 16 + j) * XS + 512 + ch] = (_Float16)siluf_(v);
      }
    }
  }
  __syncthreads();
  tick(lds, 13);

  f32x16 acc[4][2];
  zero_acc<4>(acc);
  {
    const _Float16* wp = (const _Float16*)(P.ws + OFF_WOUT) + (size_t)(wave * 4) * 64 * 512;
    const _Float16* const ab[4] = {wp, wp + 64 * 512, wp + 2 * 64 * 512, wp + 3 * 64 * 512};
    gemm_core<4, 4>(ab, lane * 8, 64, cc + r * XS + hh * 8, 32 * XS, acc);
  }
  tick(lds, 14);
  {
    const _Float16* xc = (const _Float16*)(P.ws + OFF_CC) + (size_t)(tile * 8 + wave) * 16 * 512;
#pragma unroll
    for (int i = 0; i < 4; ++i)
#pragma unroll
      for (int nt = 0; nt < 2; ++nt)
#pragma unroll
        for (int qp = 0; qp < 2; ++qp) {
          const half8 xv = *(const half8*)(xc + ((i * 2 + nt) * 2 + qp) * 512 + lane * 8);
#pragma unroll
          for (int j = 0; j < 4; ++j) {
            acc[i][nt][8 * qp + j] = fmaf(ALPHA, (float)xv[j], acc[i][nt][8 * qp + j]);
            acc[i][nt][8 * qp + 4 + j] = fmaf(ALPHA, (float)xv[4 + j], acc[i][nt][8 * qp + 4 + j]);
          }
        }
  }
  float mu[2], rs[2];
  ln_stats(acc, red, wave, lane, mu, rs);
#pragma unroll
  for (int i = 0; i < 4; ++i)
#pragma unroll
    for (int q = 0; q < 4; ++q) {
      const int ch0 = (wave * 4 + i) * 32 + q * 8 + hh * 4;
      const float4 gv = *(const float4*)(P.ln1_g + ch0), bv = *(const float4*)(P.ln1_b + ch0);
#pragma unroll
      for (int nt = 0; nt < 2; ++nt) {
        half4 hv;
        hv[0] = (_Float16)((acc[i][nt][4 * q + 0] - mu[nt]) * rs[nt] * gv.x + bv.x);
        hv[1] = (_Float16)((acc[i][nt][4 * q + 1] - mu[nt]) * rs[nt] * gv.y + bv.y);
        hv[2] = (_Float16)((acc[i][nt][4 * q + 2] - mu[nt]) * rs[nt] * gv.z + bv.z);
        hv[3] = (_Float16)((acc[i][nt][4 * q + 3] - mu[nt]) * rs[nt] * gv.w + bv.w);
        *(LAS half4*)(cc + (nt * 32 + r) * XS + ch0) = hv;
      }
    }
  __syncthreads();
  tick(lds, 15);
  LAS int* hist = (LAS int*)(lds + LDS_RED);
  if (tid < 64) hist[tid] = 0;
  LAS float* lg = (LAS float*)(lds + LDS_AUX);
  {
    const int ct = wave & 1, nt = (wave >> 1) & 1, kh = wave >> 2;
    const _Float16* ap = (const _Float16*)(P.ws + OFF_WR) + ((size_t)ct * 64 + kh * 32) * 512 + lane * 8;
    half8 rf[32];
#pragma unroll
    for (int kt = 0; kt < 32; ++kt) rf[kt] = *(const half8*)(ap + kt * 512);
    {
      _Float16* hb = (_Float16*)(P.ws + OFF_H);
#pragma unroll 8
      for (int it = 0; it < 16; ++it) {
        const int idx = tid + it * NTHREADS;
        const int row = idx >> 7, ck = idx & 127;
        const half8 v = *(const LAS half8*)(cc + row * XS + ck * 8);
        *(half8*)(hb + (size_t)(t0 + row) * D + ck * 8) = v;
      }
    }
    f32x16 ra;
#pragma unroll
    for (int g = 0; g < 16; ++g) ra[g] = 0.f;
    const LAS _Float16* bp = cc + (nt * 32 + r) * XS + kh * 512 + hh * 8;
#pragma unroll
    for (int kt = 0; kt < 32; ++kt) {
      const half8 b = *(const LAS half8*)(bp + kt * 16);
      ra = MFMA(rf[kt], b, ra);
    }
    if (kh == 1) {
#pragma unroll
      for (int g = 0; g < 16; ++g) lg[(ct * 32 + (g & 3) + 8 * (g >> 2) + 4 * hh) * 64 + nt * 32 + r] = ra[g];
    }
    __syncthreads();
    if (kh == 0) {
#pragma unroll
      for (int g = 0; g < 16; ++g) lg[(ct * 32 + (g & 3) + 8 * (g >> 2) + 4 * hh) * 64 + nt * 32 + r] += ra[g];
    }
    __syncthreads();
  }
  tick(lds, 16);
  int ex1 = 0, ex2 = 0, rk1 = 0, rk2 = 0;
  float wt1 = 0.f, wt2 = 0.f;
  if (tid < 64) {
    float lc[4];
#pragma unroll
    for (int i = 0; i < 4; ++i) lc[i] = lg[i * 64 + tid] + P.b_coarse[i];
    int g = 0; float mx = lc[0];
#pragma unroll
    for (int i = 1; i < 4; ++i) if (lc[i] > mx) { mx = lc[i]; g = i; }
    float den = 0.f;
#pragma unroll
    for (int i = 0; i < 4; ++i) den += __expf(lc[i] - mx);
    const float pg = 1.f / den;
    float sel[8];
#pragma unroll
    for (int i = 0; i < 8; ++i) sel[i] = lg[(4 + g * 8 + i) * 64 + tid] + P.b_fine[g * 8 + i];
    int e1 = 0; float m1 = sel[0];
#pragma unroll
    for (int i = 1; i < 8; ++i) if (sel[i] > m1) { m1 = sel[i]; e1 = i; }
    int e2 = -1; float m2 = -3.0e38f;
#pragma unroll
    for (int i = 0; i < 8; ++i) if (i != e1 && sel[i] > m2) { m2 = sel[i]; e2 = i; }
    const float q2 = __expf(m2 - m1);
    wt1 = pg / (1.f + q2);
    wt2 = pg * q2 / (1.f + q2);
    ex1 = g * 8 + e1; ex2 = g * 8 + e2;
    rk1 = atomicAdd((int*)&hist[ex1], 1);
    rk2 = atomicAdd((int*)&hist[ex2], 1);
  }
  __syncthreads();
  if (tid < 32) {
    const int n = hist[tid];
    int base = 0;
    if (n > 0) base = atomicAdd((int*)(P.ws + OFF_CNT) + tid, n);
    hist[32 + tid] = base;
  }
  __syncthreads();
  if (tid < 64) {
    int* list = (int*)(P.ws + OFF_LIST);
    float* wgt = (float*)(P.ws + OFF_WGT);
    const int t = t0 + tid;
    list[(size_t)ex1 * T + hist[32 + ex1] + rk1] = t * 2;
    list[(size_t)ex2 * T + hist[32 + ex2] + rk2] = t * 2 + 1;
    wgt[t * 2] = wt1;
    wgt[t * 2 + 1] = wt2;
  }
  __syncthreads();
}

constexpr int PS = 264;
__device__ void phase_l_ple(const Params& P, LAS char* lds, const int tile);
constexpr int AS = 520;
__device__ void phase_f_tile(const Params& P, LAS char* lds, const int e, const int row0, const int nrows) {
  int tid_ = threadIdx.x;
  asm volatile("" : "+v"(tid_));
  const int tid = tid_, lane = tid & 63, wave = __builtin_amdgcn_readfirstlane(tid >> 6);
  const int r = lane & 31, hh = lane >> 5;
  LAS _Float16* cc = (LAS _Float16*)(lds + LDS_TILE);
  LAS int* la = (LAS int*)(lds + LDS_RED + 256);
  LAS float* lw = (LAS float*)(lds + LDS_RED + 512);
  if (tid < 64) {
    int a = -1; float w = 0.f;
    if (tid < nrows) { a = ((const int*)(P.ws + OFF_LIST))[(size_t)e * T + row0 + tid]; w = ((const float*)(P.ws + OFF_WGT))[a]; }
    la[tid] = a; lw[tid] = w;
  }
  __syncthreads();
  {
    const _Float16* hb = (const _Float16*)(P.ws + OFF_H);
#pragma unroll 4
    for (int it = 0; it < 16; ++it) {
      const int idx = tid + it * NTHREADS;
      const int row = idx >> 7, ck = idx & 127;
      const int a = la[row];
      half8 v = {(_Float16)0.f, (_Float16)0.f, (_Float16)0.f, (_Float16)0.f, (_Float16)0.f, (_Float16)0.f, (_Float16)0.f, (_Float16)0.f};
      if (a >= 0) v = *(const half8*)(hb + (size_t)(a >> 1) * D + ck * 8);
      *(LAS half8*)(cc + row * XS + ck * 8) = v;
    }
  }
  __syncthreads();
  f32x16 acc[4][2];
  tick(lds, 18);
  zero_acc<4>(acc);
  {
    const _Float16* wg = (const _Float16*)(P.ws + OFF_WG) + (size_t)(e * 16 + wave * 2) * 64 * 512;
    const _Float16* wu = (const _Float16*)(P.ws + OFF_WU) + (size_t)(e * 16 + wave * 2) * 64 * 512;
    const _Float16* const ab[4] = {wg, wg + 64 * 512, wu, wu + 64 * 512};
    gemm_core<4, 4>(ab, lane * 8, 64, cc + r * XS + hh * 8, 32 * XS, acc);
  }
  tick(lds, 19);
  __syncthreads();
  LAS _Float16* at = (LAS _Float16*)(lds + LDS_TILE);
#pragma unroll
  for (int i = 0; i < 2; ++i)
#pragma unroll
    for (int nt = 0; nt < 2; ++nt)
#pragma unroll
      for (int q = 0; q < 4; ++q) {
        half4 hv;
#pragma unroll
        for (int j = 0; j < 4; ++j) hv[j] = (_Float16)(siluf_(acc[i][nt][4 * q + j]) * acc[i + 2][nt][4 * q + j]);
        *(LAS half4*)(at + (nt * 32 + r) * AS + wave * 64 + i * 32 + q * 8 + hh * 4) = hv;
      }
  __syncthreads();
  zero_acc<4>(acc);
  tick(lds, 20);
  {
    const _Float16* wd = (const _Float16*)(P.ws + OFF_WD) + (size_t)(e * 32 + wave * 4) * 32 * 512;
    const _Float16* const ab[4] = {wd, wd + 32 * 512, wd + 2 * 32 * 512, wd + 3 * 32 * 512};
    gemm_core<4, 4>(ab, lane * 8, 32, at + r * AS + hh * 8, 32 * AS, acc);
  }
  tick(lds, 21);
  __syncthreads();
  {
    const float w0 = lw[r], w1 = lw[32 + r];
#pragma unroll
    for (int i = 0; i < 4; ++i)
#pragma unroll
      for (int nt = 0; nt < 2; ++nt)
#pragma unroll
        for (int q = 0; q < 4; ++q) {
          const float w = nt ? w1 : w0;
          half4 hv;
#pragma unroll
          for (int j = 0; j < 4; ++j) hv[j] = (_Float16)(acc[i][nt][4 * q + j] * w);
          *(LAS half4*)(cc + (nt * 32 + r) * XS + (wave * 4 + i) * 32 + q * 8 + hh * 4) = hv;
        }
  }
  __syncthreads();
  {
    _Float16* yb = (_Float16*)(P.ws + OFF_YB);
#pragma unroll 4
    for (int it = 0; it < 16; ++it) {
      const int idx = tid + it * NTHREADS;
      const int row = idx >> 7, ck = idx & 127;
      const int a = la[row];
      if (a >= 0) *(half8*)(yb + (size_t)a * D + ck * 8) = *(const LAS half8*)(cc + row * XS + ck * 8);
    }
  }
  __syncthreads();
}

__device__ int phase_f(const Params& P, LAS char* lds, const unsigned xcc, const unsigned xrank) {
  LAS int* sm = (LAS int*)(lds + LDS_RED);
  const int* counts = (const int*)(P.ws + OFF_CNT);
  if (threadIdx.x == 0) {
    int a = 0;
    for (int e = 0; e < NEXP; ++e) { sm[e] = a; a += (counts[e] + 63) >> 6; }
    sm[32] = a;
  }
  __syncthreads();
  const int total = sm[32];
  int vb = 0;
  for (unsigned x = 0; x < xcc; ++x) vb += (int)__hip_atomic_load((unsigned*)(P.ws + OFF_CNT + 2048) + 16 * x, __ATOMIC_RELAXED, __HIP_MEMORY_SCOPE_AGENT);
  vb += (int)xrank;
  for (int vt = vb; vt < total; vt += gridDim.x) {
    int e = 0;
    for (int i = 1; i < NEXP; ++i) e += (sm[i] <= vt) ? 1 : 0;
    const int row0 = (vt - sm[e]) * 64;
    const int cnt = counts[e];
    const int nrows = (cnt - row0 < 64) ? (cnt - row0) : 64;
    phase_f_tile(P, lds, e, row0, nrows);
  }
  const int G = gridDim.x, rem = total % G;
  if (vb >= rem) {
    for (int t = vb; t < NTILES; t += G) phase_l_ple(P, lds, t);
    if (rem > 0) {
      const int per = (NTILES + G - 1) / G;
      for (int o = vb - rem; o < rem * per; o += G - rem) {
        const int t = (o % rem) + (o / rem) * G;
        if (t < NTILES) phase_l_ple(P, lds, t);
      }
    }
  }
  return vb;
}

__device__ void phase_l_ple(const Params& P, LAS char* lds, const int tile) {
  int tid_ = threadIdx.x;
  asm volatile("" : "+v"(tid_));
  const int tid = tid_, lane = tid & 63, wave = __builtin_amdgcn_readfirstlane(tid >> 6);
  const int r = lane & 31, hh = lane >> 5;
  const int t0 = tile * 64;
  LAS _Float16* cc = (LAS _Float16*)(lds + LDS_TILE);
  _Float16* scr = (_Float16*)(P.ws + OFF_Z) + (size_t)tile * 16 * NTHREADS * 8;
  {
    LAS _Float16* pt = (LAS _Float16*)(lds + LDS_TILE);
#pragma unroll
    for (int it = 0; it < 8; ++it) {
      const int idx = tid + it * NTHREADS;
      const int row = idx >> 6, c4 = idx & 63;
      const float4 v = *(const float4*)(P.p + (size_t)(t0 + row) * DPLE + c4 * 4);
      half4 hv = {(_Float16)v.x, (_Float16)v.y, (_Float16)v.z, (_Float16)v.w};
      *(LAS half4*)(pt + row * PS + c4 * 4) = hv;
    }
  }
  __syncthreads();
  f32x16 acc[4][2];
  zero_acc<4>(acc);
  {
    const _Float16* wp = (const _Float16*)(P.ws + OFF_WPP) + (size_t)(wave * 4) * 16 * 512;
    const _Float16* const ab[4] = {wp, wp + 16 * 512, wp + 2 * 16 * 512, wp + 3 * 16 * 512};
    gemm_core<4, 4>(ab, lane * 8, 16, cc + r * PS + hh * 8, 32 * PS, acc);
  }
#pragma unroll
  for (int i = 0; i < 4; ++i)
#pragma unroll
    for (int nt = 0; nt < 2; ++nt)
#pragma unroll
      for (int hf = 0; hf < 2; ++hf) {
        half8 hv;
#pragma unroll
        for (int j = 0; j < 8; ++j) hv[j] = (_Float16)acc[i][nt][hf * 8 + j];
        *(half8*)(scr + ((size_t)((i * 2 + nt) * 2 + hf) * NTHREADS + tid) * 8) = hv;
      }
  __syncthreads();
}

__device__ void phase_l_tile(const Params& P, LAS char* lds, const int tile) {
  int tid_ = threadIdx.x;
  asm volatile("" : "+v"(tid_));
  const int tid = tid_, lane = tid & 63, wave = __builtin_amdgcn_readfirstlane(tid >> 6);
  const int r = lane & 31, hh = lane >> 5;
  const int t0 = tile * 64;
  LAS _Float16* cc = (LAS _Float16*)(lds + LDS_TILE);
  LAS float* red = (LAS float*)(lds + LDS_RED);
  const _Float16* scr = (const _Float16*)(P.ws + OFF_Z) + (size_t)tile * 16 * NTHREADS * 8;
  f32x16 acc[4][2];
  {
    const _Float16* hb = (const _Float16*)(P.ws + OFF_H);
    const _Float16* yb = (const _Float16*)(P.ws + OFF_YB);
    float g2[16], b2[16];
#pragma unroll
    for (int hf = 0; hf < 2; ++hf)
#pragma unroll
      for (int j4 = 0; j4 < 2; ++j4) {
        const float4 gv = *(const float4*)(P.ln2_g + hf * 512 + lane * 8 + j4 * 4), bv = *(const float4*)(P.ln2_b + hf * 512 + lane * 8 + j4 * 4);
        g2[hf * 8 + j4 * 4 + 0] = gv.x; g2[hf * 8 + j4 * 4 + 1] = gv.y; g2[hf * 8 + j4 * 4 + 2] = gv.z; g2[hf * 8 + j4 * 4 + 3] = gv.w;
        b2[hf * 8 + j4 * 4 + 0] = bv.x; b2[hf * 8 + j4 * 4 + 1] = bv.y; b2[hf * 8 + j4 * 4 + 2] = bv.z; b2[hf * 8 + j4 * 4 + 3] = bv.w;
      }
#pragma unroll 2
    for (int k = 0; k < 8; ++k) {
      const int row = wave * 8 + k;
      const size_t t = (size_t)(t0 + row);
      float v[16];
      float s = 0.f, ss = 0.f;
#pragma unroll
      for (int hf = 0; hf < 2; ++hf) {
        const half8 hv = *(const half8*)(hb + t * D + hf * 512 + lane * 8);
        const half8 y0 = *(const half8*)(yb + (2 * t) * D + hf * 512 + lane * 8);
        const half8 y1 = *(const half8*)(yb + (2 * t + 1) * D + hf * 512 + lane * 8);
#pragma unroll
        for (int j = 0; j < 8; ++j) {
          const float x = fmaf(ALPHA, (float)hv[j], (float)y0[j] + (float)y1[j]);
          v[hf * 8 + j] = x; s += x; ss = fmaf(x, x, ss);
        }
      }
#pragma unroll
      for (int o = 32; o > 0; o >>= 1) { s += __shfl_xor(s, o); ss += __shfl_xor(ss, o); }
      const float m = s * (1.f / D);
      const float rsd = rsqrtf(fmaxf(ss * (1.f / D) - m * m, 0.f) + EPS);
#pragma unroll
      for (int hf = 0; hf < 2; ++hf) {
        half8 o8;
#pragma unroll
        for (int j = 0; j < 8; ++j) o8[j] = (_Float16)((v[hf * 8 + j] - m) * rsd * g2[hf * 8 + j] + b2[hf * 8 + j]);
        *(LAS half8*)(cc + row * XS + hf * 512 + lane * 8) = o8;
      }
    }
  }
  __syncthreads();
  zero_acc<4>(acc);
  tick(lds, 25);
  {
    const _Float16* wp = (const _Float16*)(P.ws + OFF_WPG) + (size_t)(wave * 4) * 64 * 512;
    const _Float16* const ab[4] = {wp, wp + 64 * 512, wp + 2 * 64 * 512, wp + 3 * 64 * 512};
    gemm_core<4, 2>(ab, lane * 8, 64, cc + r * XS + hh * 8, 32 * XS, acc);
  }
  tick(lds, 26);
#pragma unroll
  for (int i = 0; i < 4; ++i)
#pragma unroll
    for (int nt = 0; nt < 2; ++nt)
#pragma unroll
      for (int hf = 0; hf < 2; ++hf) {
        const half8 pv = *(const half8*)(scr + ((size_t)((i * 2 + nt) * 2 + hf) * NTHREADS + tid) * 8);
#pragma unroll
        for (int q2 = 0; q2 < 2; ++q2) {
          const int q = hf * 2 + q2;
          const half4 yv = *(const LAS half4*)(cc + (nt * 32 + r) * XS + (wave * 4 + i) * 32 + q * 8 + hh * 4);
#pragma unroll
          for (int j = 0; j < 4; ++j) {
            const float gate = sigmoidf_(acc[i][nt][4 * q + j]);
            acc[i][nt][4 * q + j] = fmaf(ALPHA, (float)yv[j], (float)pv[q2 * 4 + j] * gate);
          }
        }
      }
  float mu[2], rs[2];
  ln_stats(acc, red, wave, lane, mu, rs);
  tick(lds, 27);
#pragma unroll
  for (int i = 0; i < 4; ++i)
#pragma unroll
    for (int q = 0; q < 4; ++q) {
      const int ch0 = (wave * 4 + i) * 32 + q * 8 + hh * 4;
      const float4 gv = *(const float4*)(P.ln3_g + ch0), bv = *(const float4*)(P.ln3_b + ch0);
#pragma unroll
      for (int nt = 0; nt < 2; ++nt) {
        float4 o;
        o.x = (acc[i][nt][4 * q + 0] - mu[nt]) * rs[nt] * gv.x + bv.x;
        o.y = (acc[i][nt][4 * q + 1] - mu[nt]) * rs[nt] * gv.y + bv.y;
        o.z = (acc[i][nt][4 * q + 2] - mu[nt]) * rs[nt] * gv.z + bv.z;
        o.w = (acc[i][nt][4 * q + 3] - mu[nt]) * rs[nt] * gv.w + bv.w;
        *(float4*)(P.out + (size_t)(t0 + nt * 32 + r) * D + ch0) = o;
      }
    }
  __syncthreads();
}

#define XB_TMO      128
#define XB_XCNT(j)  (256  + 64 * (j))
#define XB_XSUB(j)  (1280 + 64 * (j))
#define XB_XGEN(j)  (2304 + 64 * (j))
#define XB_TOP      3328
#define XB_TOPGEN   3392
#define XCD_BAR_WORDS 3456
#define XB_SPIN_CAP (1u << 18)
__device__ __forceinline__ unsigned xb_ld(unsigned* p)              { return __hip_atomic_load(p, __ATOMIC_RELAXED, __HIP_MEMORY_SCOPE_AGENT); }
__device__ __forceinline__ unsigned xb_add(unsigned* p, unsigned v) { return __hip_atomic_fetch_add(p, v, __ATOMIC_RELAXED, __HIP_MEMORY_SCOPE_AGENT); }
__device__ __forceinline__ unsigned xb_xcc_id() { return (unsigned)__builtin_amdgcn_s_getreg((3 << 11) | 20) & 0xFu; }
#define XB_SPIN(cond, bar) do { unsigned _sp = 0; while (cond) { __builtin_amdgcn_s_sleep(1); \
    if ((++_sp & 255u) == 0u) { if (xb_ld(&(bar)[XB_TMO])) break; if (_sp > XB_SPIN_CAP) { atomicAdd(&(bar)[XB_TMO], 1u); break; } } } } while (0)
struct XcdBarrier { unsigned* bar; unsigned x; volatile LAS unsigned* st; };
__device__ __forceinline__ XcdBarrier xcd_barrier_post(unsigned* bar, volatile LAS unsigned* st) {
  XcdBarrier b; b.bar = bar; b.x = xb_xcc_id(); b.st = st;
  if (threadIdx.x == 0) (void)xb_add(&bar[XB_XCNT(b.x)], 1u);
  return b;
}
__device__ __forceinline__ void xcd_barrier_complete(unsigned* bar, unsigned x, unsigned& nloc, unsigned& nx) {
  const unsigned G = gridDim.x * gridDim.y * gridDim.z;
  unsigned sum, cnt, mine, sp = 0u;
  for (;;) {
    sum = 0u; cnt = 0u; mine = 0u;
#pragma unroll
    for (unsigned j = 0; j < 16; ++j) { const unsigned c = xb_ld(&bar[XB_XCNT(j)]); sum += c; cnt += (c > 0u) ? 1u : 0u; mine = (j == x) ? c : mine; }
    if (sum == G) break;
    __builtin_amdgcn_s_sleep(1);
    if ((++sp & 255u) == 0u) { if (xb_ld(&bar[XB_TMO])) break; if (sp > XB_SPIN_CAP) { atomicAdd(&bar[XB_TMO], 1u); break; } }
  }
  nloc = mine > 0u ? mine : 1u; nx = cnt > 0u ? cnt : 1u;
}
__device__ __forceinline__ void xcd_barrier(const XcdBarrier& b) {
  asm volatile("s_waitcnt vmcnt(0)" ::: "memory");
  __syncthreads();
  if (threadIdx.x == 0) {
    unsigned* bar = b.bar;
    __builtin_amdgcn_s_waitcnt(0);
    unsigned nloc = b.st[0], nx = b.st[1];
    if (nloc == 0u) { xcd_barrier_complete(bar, b.x, nloc, nx); b.st[0] = nloc; b.st[1] = nx; }
    const unsigned old = xb_add(&bar[XB_XSUB(b.x)], 1u);
    const unsigned gen = old / nloc;
    if (old + 1u == (gen + 1u) * nloc) {
      __builtin_amdgcn_fence(__ATOMIC_RELEASE, "agent");
      asm volatile("s_waitcnt vmcnt(0)" ::: "memory");
      const unsigned og = xb_add(&bar[XB_TOP], 1u);
      const unsigned tg = og / nx;
      if (og + 1u == (tg + 1u) * nx) xb_add(&bar[XB_TOPGEN], 1u);
      else XB_SPIN(xb_ld(&bar[XB_TOPGEN]) == tg, bar);
      __builtin_amdgcn_fence(__ATOMIC_ACQUIRE, "agent");
      xb_add(&bar[XB_XGEN(b.x)], 1u);
      asm volatile("s_waitcnt vmcnt(0)" ::: "memory");
    } else {
      XB_SPIN(xb_ld(&bar[XB_XGEN(b.x)]) == gen, bar);
      __builtin_amdgcn_fence(__ATOMIC_ACQUIRE, "agent");
      asm volatile("s_waitcnt vmcnt(0)" ::: "memory");
    }
  }
  __syncthreads();
}

__global__ void __launch_bounds__(NTHREADS) k_mega(Params P) {
  extern __shared__ __attribute__((aligned(16))) char lds_raw[];
  LAS char* lds = (LAS char*)lds_raw;
  if (threadIdx.x < 4) ((LAS unsigned*)(lds + LDS_BAR))[threadIdx.x] = 0u;
  __syncthreads();
  if (PROBE_ON && threadIdx.x < 64) ((LAS unsigned long long*)(lds + LDS_PROF))[threadIdx.x] = 0ull;
  if (PROBE_ON) __syncthreads();
  if (PROBE_ON && blockIdx.x == 0 && threadIdx.x == 448) ((LAS unsigned long long*)(lds + LDS_PROF))[0] = __builtin_amdgcn_s_memrealtime();
  const XcdBarrier bar = xcd_barrier_post((unsigned*)(P.ws + OFF_BAR), (volatile LAS unsigned*)(lds + LDS_BAR));
  if (threadIdx.x == 0) ((LAS unsigned*)(lds + LDS_BAR))[2] = xb_add((unsigned*)(P.ws + OFF_CNT + 2048) + 16 * bar.x, 1u);
  phase_pack(P);
  tick(lds, 0);
  xcd_barrier(bar);
  tick(lds, 1);
  const bool pack_first = ((blockIdx.x >> 3) & 1) != 0;
  if (pack_first) pack_experts_all(P);
  for (int tile = blockIdx.x; tile < NTILES; tile += gridDim.x) phase_z_tile(P, lds, tile, false);
  if (!pack_first) pack_experts_all(P);
  tick(lds, 12);
  xcd_barrier(bar);
  tick(lds, 3);
  {
    const int ntb = (NTILES - 1 - (int)blockIdx.x) / (int)gridDim.x;
    for (int tile = blockIdx.x + ntb * gridDim.x; tile >= (int)blockIdx.x; tile -= gridDim.x) phase_m_tile(P, lds, tile);
  }
  tick(lds, 17);
  xcd_barrier(bar);
  tick(lds, 5);
  const int vb = phase_f(P, lds, bar.x, ((LAS unsigned*)(lds + LDS_BAR))[2]);
  tick(lds, 22);
  xcd_barrier(bar);
  tick(lds, 7);
  for (int tile = vb; tile < NTILES; tile += gridDim.x) phase_l_tile(P, lds, tile);
  tick(lds, 28);
  if (PROBE_ON && blockIdx.x == 0) {
    if (threadIdx.x == 448) {
      LAS unsigned long long* pf = (LAS unsigned long long*)(lds + LDS_PROF);
      unsigned long long d = 0;
      for (int k = 0; k < 40; ++k) if ((PROBE_MASK >> k) & 1ull) d += pf[1 + k];
      d *= PROBE_MULT;
      const unsigned long long t_end = __builtin_amdgcn_s_memrealtime();
      while (__builtin_amdgcn_s_memrealtime() - t_end < d) __builtin_amdgcn_s_sleep(8);
    }
    __syncthreads();
  }
}
}

static Params make_params(void* const* d_in, void* d_out, void* d_ws) {
  Params P{};
  const float** f = (const float**)&P;
  for (int i = 0; i < 25; ++i) f[i] = (const float*)d_in[i];
  P.out = (float*)d_out;
  P.ws = (char*)d_ws;
  return P;
}

extern "C" void kernel_launch(void* const* d_in, const int* in_sizes, int n_in, void* d_out, int out_size, void* d_ws, size_t ws_size, hipStream_t stream) {
  static int grid = 0;
  if (grid == 0) {
    if (ws_size < OFF_END || n_in != 25) { fprintf(stderr, "kernel_launch: bad ws/n_in: %zu < %zu, n_in %d\n", ws_size, (size_t)OFF_END, n_in); grid = -1; return; }
    int dev = 0, cus = 0, per_cu = 0;
    (void)hipGetDevice(&dev);
    (void)hipDeviceGetAttribute(&cus, hipDeviceAttributeMultiprocessorCount, dev);
    (void)hipFuncSetAttribute((const void*)k_mega, hipFuncAttributeMaxDynamicSharedMemorySize, LDS_BYTES);
    (void)hipOccupancyMaxActiveBlocksPerMultiprocessor(&per_cu, (const void*)k_mega, NTHREADS, LDS_BYTES);
    if (per_cu < 1) { fprintf(stderr, "kernel_launch: occupancy query says %d blocks/CU\n", per_cu); }
    (void)hipGetLastError();
    grid = cus;
  }
  if (grid < 0) return;
  (void)hipMemsetAsync(d_ws, 0, CTRL_BYTES, stream);
  Params P = make_params(d_in, d_out, d_ws);
  void* args[] = {&P};
  hipError_t e = hipLaunchCooperativeKernel((const void*)k_mega, dim3(grid), dim3(NTHREADS), args, LDS_BYTES, stream);
  if (e != hipSuccess) fprintf(stderr, "kernel_launch: cooperative launch failed: %s (grid %d)\n", hipGetErrorString(e), grid);
}
```
